# Optimizing an MI355X kernel written in HIP

```python
import math
import jax, jax.numpy as jnp
from jax import lax
import numpy as np

D_MODEL = 1024
BATCH = 8
SEQ = 2048
DEPTH = 4
DEC_BATCH = 16
DEC_SEQ = 2048
PAST_LEN = 128

N_MIXERS = 2
N_ATTN_LAYERS = (DEPTH + 1) // 2
N_CONV_LAYERS = DEPTH // 2
ATTN_HEAD_DIM = 128
ATTN_HEADS = D_MODEL // ATTN_HEAD_DIM
WINDOWS = (128, 512, 2048)
DILATIONS = (1, 4, 16)
N_GROUPS = len(WINDOWS)
QKV_COLS = N_GROUPS * 3 * ATTN_HEADS * ATTN_HEAD_DIM
ROPE_THETA = 500000.0
ROT_DIM = ATTN_HEAD_DIM // 4
NEG_INF = -1e30
CONV_WIDTH = 3
PEER_HEADS = 8
PEER_N_KEYS = 128
PEER_N_EXPERTS = PEER_N_KEYS * PEER_N_KEYS
PEER_QUERY_DIM = 256
PEER_HALF = PEER_QUERY_DIM // 2
PEER_TOPK = 16
PEER_CHUNK = 128
PLE_DIM = 256
DEEPNORM_ALPHA = (2.0 * DEPTH) ** 0.25
DEEPNORM_BETA = (8.0 * DEPTH) ** -0.25
LN_EPS = 1e-5

kernel_name = "hybrid_dilated_attn_shortconv_peer_encoder"


def layer_norm(x, g, b):
    xf = x.astype(jnp.float32)
    mu = jnp.mean(xf, axis=-1, keepdims=True)
    xc = xf - mu
    var = jnp.mean(xc * xc, axis=-1, keepdims=True)
    return (xc * lax.rsqrt(var + LN_EPS) * g.astype(jnp.float32) + b.astype(jnp.float32)).astype(x.dtype)


def rope_tables(seq_len):
    inv_freq = ROPE_THETA ** (-jnp.arange(0, ROT_DIM, 2, dtype=jnp.float32) / ROT_DIM)
    ang = jnp.arange(seq_len, dtype=jnp.float32)[:, None] * inv_freq[None, :]
    return jnp.cos(ang), jnp.sin(ang)


def apply_partial_rope(t, cos, sin):
    rot = t[..., :ROT_DIM].astype(jnp.float32)
    x1, x2 = rot[..., :ROT_DIM // 2], rot[..., ROT_DIM // 2:]
    c, s = cos[None, :, None, :], sin[None, :, None, :]
    rotated = jnp.concatenate([x1 * c - x2 * s, x2 * c + x1 * s], axis=-1).astype(t.dtype)
    return jnp.concatenate([rotated, t[..., ROT_DIM:]], axis=-1)


def dilated_window_attention(q, k, v, dil, steps):
    B, S, H, Dh = q.shape
    L = S // dil
    Lp = -(-L // steps) * steps
    nb = Lp // steps
    pad = Lp - L
    Bd = B * dil

    def to_res(t):
        return t.reshape(B, L, dil, H, Dh).transpose(0, 2, 1, 3, 4).reshape(Bd, L, H, Dh)

    qb = jnp.pad(to_res(q), ((0, 0), (0, pad), (0, 0), (0, 0))).reshape(Bd, nb, steps, H, Dh)

    def windows(t):
        tp = jnp.pad(to_res(t), ((0, 0), (steps, steps + pad), (0, 0), (0, 0)))
        tp = tp.reshape(Bd, nb + 2, steps, H, Dh)
        return jnp.concatenate([tp[:, :-2], tp[:, 1:-1], tp[:, 2:]], axis=2)

    kw, vw = windows(k), windows(v)
    qpos = jnp.arange(Lp).reshape(nb, steps)
    kpos = jnp.arange(nb)[:, None] * steps - steps + jnp.arange(3 * steps)[None, :]
    dq = qpos[:, :, None] - kpos[:, None, :]
    valid = (jnp.abs(dq) <= steps) & (kpos[:, None, :] >= 0) & (kpos[:, None, :] < L)

    scale = 1.0 / math.sqrt(Dh)
    s = jnp.einsum('xnqhd,xnkhd->xnhqk', qb, kw).astype(jnp.float32) * scale
    s = jnp.where(valid[None, :, None], s, NEG_INF)
    m = jnp.max(s, axis=-1, keepdims=True)
    p = jnp.exp(s - m)
    den = jnp.sum(p, axis=-1)
    o = jnp.einsum('xnhqk,xnkhd->xnqhd', p, vw.astype(jnp.float32))
    o = o / jnp.transpose(den, (0, 1, 3, 2))[..., None]
    lse = m[..., 0] + jnp.log(den)

    o = o.reshape(Bd, Lp, H, Dh)[:, :L]
    o = o.reshape(B, dil, L, H, Dh).transpose(0, 2, 1, 3, 4).reshape(B, S, H, Dh)
    lse = jnp.transpose(lse, (0, 1, 3, 2)).reshape(Bd, Lp, H)[:, :L]
    lse = lse.reshape(B, dil, L, H).transpose(0, 2, 1, 3).reshape(B, S, H)
    return o, lse


def dilated_mixture_attention(x, w_qkv, w_out):
    B, S, _ = x.shape
    qkv = (x @ w_qkv).reshape(B, S, N_GROUPS, 3, ATTN_HEADS, ATTN_HEAD_DIM)
    cos, sin = rope_tables(S)
    outs, lses = [], []
    for g in range(N_GROUPS):
        dil = DILATIONS[g]
        steps = WINDOWS[g] // (2 * dil)
        q = apply_partial_rope(qkv[:, :, g, 0], cos, sin)
        k = apply_partial_rope(qkv[:, :, g, 1], cos, sin)
        o, lse = dilated_window_attention(q, k, qkv[:, :, g, 2], dil, steps)
        outs.append(o)
        lses.append(lse)
    wgt = jax.nn.softmax(jnp.stack(lses, axis=0), axis=0)
    o = jnp.sum(wgt[..., None] * jnp.stack(outs, axis=0), axis=0).astype(x.dtype)
    return o.reshape(B, S, ATTN_HEADS * ATTN_HEAD_DIM) @ w_out


def short_conv_mixer(x, w_in, conv_kernel, w_out):
    gb, gc, xv = jnp.split(x @ w_in, 3, axis=-1)
    h = gc * xv
    hp = jnp.pad(h, ((0, 0), (1, 1), (0, 0)))
    conv = hp[:, :-2] * conv_kernel[0] + hp[:, 1:-1] * conv_kernel[1] + hp[:, 2:] * conv_kernel[2]
    return (gb * conv) @ w_out


def peer_channel_mixer(x, w_query, sub_keys, u_tab, v_tab):
    B, S, D = x.shape
    xt = x.reshape(-1, PEER_CHUNK, D)

    def block(xc):
        C = xc.shape[0]
        q = (xc @ w_query).reshape(C, PEER_HEADS, 2, PEER_HALF)
        s = jnp.einsum('chpk,hpnk->chpn', q, sub_keys).astype(jnp.float32)
        sv, si = lax.top_k(s, PEER_TOPK)
        cand = (sv[:, :, 0, :, None] + sv[:, :, 1, None, :]).reshape(C, PEER_HEADS, PEER_TOPK * PEER_TOPK)
        cidx = (si[:, :, 0, :, None] * PEER_N_KEYS + si[:, :, 1, None, :]).reshape(C, PEER_HEADS, PEER_TOPK * PEER_TOPK)
        fv, fi = lax.top_k(cand, PEER_TOPK)
        eidx = jnp.take_along_axis(cidx, fi, axis=-1)
        g = jax.nn.softmax(fv, axis=-1)
        u = u_tab[eidx]
        h = jax.nn.gelu(jnp.einsum('chkd,cd->chk', u, xc).astype(jnp.float32), approximate=False)
        coef = (g * h).astype(xc.dtype)
        return jnp.einsum('chk,chkd->cd', coef, v_tab[eidx])

    return lax.map(block, xt).reshape(B, S, D)


def trunk(x, p, attn_w_qkv, attn_w_out, conv_w_in, conv_kernel, conv_w_out,
          peer_w_query, peer_sub_keys, peer_u, peer_v,
          ln1_gain, ln1_bias, ln2_gain, ln2_bias, ple_w_proj, ple_w_gate):
    for i in range(DEPTH):
        j = i // N_MIXERS
        if i % N_MIXERS == 0:
            h = dilated_mixture_attention(x, attn_w_qkv[j], attn_w_out[j])
        else:
            h = short_conv_mixer(x, conv_w_in[j], conv_kernel[j], conv_w_out[j])
        x = layer_norm(DEEPNORM_ALPHA * x + h, ln1_gain[i], ln1_bias[i])
        f = peer_channel_mixer(x, peer_w_query[i], peer_sub_keys[i], peer_u[i], peer_v[i])
        x = layer_norm(DEEPNORM_ALPHA * x + f, ln2_gain[i], ln2_bias[i])
        x = x + jax.nn.sigmoid(x @ ple_w_gate[i]) * (p[i] @ ple_w_proj[i])
    return x


def setup_inputs(seed: int = 0) -> dict:
    key = jax.random.key(seed)
    ks = jax.random.split(key, 20)
    f32 = jnp.float32
    D = D_MODEL
    nrm = lambda k, shape, scale: jax.random.normal(k, shape, f32) * scale
    return {
        "x_prompt": nrm(ks[0], (BATCH, SEQ, D), 1.0),
        "x_sample": nrm(ks[1], (DEC_BATCH, DEC_SEQ, D), 1.0),
        "p_prompt": nrm(ks[2], (DEPTH, BATCH, SEQ, PLE_DIM), 1.0),
        "p_sample": nrm(ks[3], (DEPTH, DEC_BATCH, DEC_SEQ, PLE_DIM), 1.0),
        "attn_w_qkv": nrm(ks[4], (N_ATTN_LAYERS, D, QKV_COLS), D ** -0.5),
        "attn_w_out": nrm(ks[5], (N_ATTN_LAYERS, ATTN_HEADS * ATTN_HEAD_DIM, D), DEEPNORM_BETA * (ATTN_HEADS * ATTN_HEAD_DIM) ** -0.5),
        "conv_w_in": nrm(ks[6], (N_CONV_LAYERS, D, 3 * D), D ** -0.5),
        "conv_kernel": nrm(ks[7], (N_CONV_LAYERS, CONV_WIDTH, D), CONV_WIDTH ** -0.5),
        "conv_w_out": nrm(ks[8], (N_CONV_LAYERS, D, D), DEEPNORM_BETA * D ** -0.5),
        "peer_w_query": nrm(ks[9], (DEPTH, D, PEER_HEADS * PEER_QUERY_DIM), D ** -0.5),
        "peer_sub_keys": nrm(ks[10], (DEPTH, PEER_HEADS, 2, PEER_N_KEYS, PEER_HALF), PEER_HALF ** -0.5),
        "peer_u": nrm(ks[11], (DEPTH, PEER_N_EXPERTS, D), D ** -0.5),
        "peer_v": nrm(ks[12], (DEPTH, PEER_N_EXPERTS, D), DEEPNORM_BETA * PEER_HEADS ** -0.5),
        "ln1_gain": 1.0 + nrm(ks[13], (DEPTH, D), 0.01),
        "ln1_bias": nrm(ks[14], (DEPTH, D), 0.01),
        "ln2_gain": 1.0 + nrm(ks[15], (DEPTH, D), 0.01),
        "ln2_bias": nrm(ks[16], (DEPTH, D), 0.01),
        "ple_w_proj": nrm(ks[17], (DEPTH, PLE_DIM, D), PLE_DIM ** -0.5),
        "ple_w_gate": nrm(ks[18], (DEPTH, D, D), D ** -0.5),
    }


def reference(x_prompt, x_sample, p_prompt, p_sample, attn_w_qkv, attn_w_out, conv_w_in,
              conv_kernel, conv_w_out, peer_w_query, peer_sub_keys, peer_u, peer_v,
              ln1_gain, ln1_bias, ln2_gain, ln2_bias, ple_w_proj, ple_w_gate):
    y_prompt = trunk(x_prompt, p_prompt, attn_w_qkv, attn_w_out, conv_w_in, conv_kernel, conv_w_out,
                     peer_w_query, peer_sub_keys, peer_u, peer_v,
                     ln1_gain, ln1_bias, ln2_gain, ln2_bias, ple_w_proj, ple_w_gate)
    y_sample = trunk(x_sample, p_sample, attn_w_qkv, attn_w_out, conv_w_in, conv_kernel, conv_w_out,
                     peer_w_query, peer_sub_keys, peer_u, peer_v,
                     ln1_gain, ln1_bias, ln2_gain, ln2_bias, ple_w_proj, ple_w_gate)
    return (y_prompt, y_sample)
```

```cpp
#include <hip/hip_runtime.h>
#include <stdint.h>
#include <stdio.h>
namespace pg8 {
#define PG8_LAS __attribute__((address_space(3)))
typedef unsigned short bf16_t;
typedef short bf16x8 __attribute__((ext_vector_type(8)));
typedef float f32x4 __attribute__((ext_vector_type(4)));
typedef unsigned u32x4 __attribute__((ext_vector_type(4)));
constexpr int BM = 256, BK = 64, HALF = 128, HTB = HALF * BK * 2  , STAGE_BYTES = 8 * HTB, NXCD = 8, WGM = 8;

__host__ __device__ __forceinline__ int lds_byte(int r, int c) { const int st = (r >> 4) * 2 + (c >> 5), rr = r & 15, cc = c & 31, ob = rr * 64 + cc * 2; return st * 1024 + (ob ^ (((ob >> 9) & 1) << 5)); }
__host__ __device__ __forceinline__ void stage_rc(int b, int& R, int& C) { const int st = b / 1024, sb = b % 1024, swz = sb ^ (((sb >> 9) & 1) << 5); R = (st >> 1) * 16 + swz / 64; C = (st & 1) * 32 + (swz % 64) / 2; }
__host__ __device__ __forceinline__ int perm32(int rho) { const int n = rho >> 4, i = rho & 15; return 8 * (i >> 2) + 4 * n + (i & 3); }

struct Unit { int pm, pn; };
struct Gemm { const bf16_t* A; const bf16_t* Bt; int M, N, K; };

struct StaticOrder {
    int nM, nN, nwg, G, c;
    __host__ __device__ void init(int M, int N, int G_, int c_) { nM = M / BM; nN = N / BM; nwg = nM * nN; G = G_; c = c_; }
    __host__ __device__ bool next(int i, Unit& u) const {
        const long L = (long)i * G + c; if (L >= nwg) return false;
        int wgid = (int)L; { const int q = nwg / NXCD, r = nwg % NXCD, xcd = wgid % NXCD, off = wgid / NXCD; wgid = (xcd < r ? xcd * (q + 1) : r * (q + 1) + (xcd - r) * q) + off; }
        const int nig = WGM * nN, gid = wgid / nig, fm = gid * WGM, gsz = (nM - fm) < WGM ? (nM - fm) : WGM;
        u.pm = fm + ((wgid % nig) % gsz); u.pn = (wgid % nig) / gsz; return true;
    }
    __device__ __forceinline__ void a_ready(const Unit&) const {}
    __device__ __forceinline__ void done(const Unit&) const {}
};
struct CountedOrder : StaticOrder {
    const unsigned* ready; unsigned need; unsigned* tmo;
    __device__ __forceinline__ void a_ready(const Unit& u) const {
        if (threadIdx.x < 64) {
            const unsigned long long t0 = __builtin_amdgcn_s_memrealtime(); unsigned polls = 0;
            while ((unsigned)__builtin_amdgcn_readfirstlane(__hip_atomic_load(ready + 64 * u.pm, __ATOMIC_RELAXED, __HIP_MEMORY_SCOPE_AGENT)) < need) {
                if ((++polls & 255u) == 0u && __builtin_amdgcn_readfirstlane(__hip_atomic_load(tmo, __ATOMIC_RELAXED, __HIP_MEMORY_SCOPE_AGENT)) != 0u) break;
                if (__builtin_amdgcn_s_memrealtime() - t0 > 2000000ull) {
                    if (threadIdx.x == 0) { unsigned expect = 0u; __hip_atomic_compare_exchange_strong(tmo + 1, &expect, 0x600u | (unsigned)(u.pm & 0xff), __ATOMIC_RELAXED, __ATOMIC_RELAXED, __HIP_MEMORY_SCOPE_AGENT); __hip_atomic_store(tmo, 1u, __ATOMIC_RELAXED, __HIP_MEMORY_SCOPE_AGENT); }
                    break; }
                __builtin_amdgcn_s_sleep(2); }
            __builtin_amdgcn_fence(__ATOMIC_ACQUIRE, "agent");
            asm volatile("s_waitcnt vmcnt(0)" ::: "memory");
        }
#if !defined(BROKEN_HOOK_NO_BARRIER)
        asm volatile("" ::: "memory"); __builtin_amdgcn_s_barrier(); asm volatile("" ::: "memory");
#endif
    }
};

__device__ __forceinline__ unsigned cvt_pk_bf16(float lo, float hi) { unsigned r; asm volatile("v_cvt_pk_bf16_f32 %0, %1, %2" : "=v"(r) : "v"(lo), "v"(hi)); return r; }
typedef float f32x2 __attribute__((ext_vector_type(2)));
__device__ __forceinline__ f32x2 gelu_pk(f32x2 v) {
    const f32x2 av = __builtin_elementwise_abs(v), d = av * 0.2316418882f + 1.0f;
    f32x2 t; t.x = __builtin_amdgcn_rcpf(d.x); t.y = __builtin_amdgcn_rcpf(d.y);
    f32x2 q = t * 0.5307027145f + (-0.7265760135f); q = q * t + 0.7107068705f; q = q * t + (-0.142248368f); q = q * t + 0.127414796f; q = q * t;
    const f32x2 s = (v * v) * (-0.72134752044f);
    f32x2 e; e.x = __builtin_amdgcn_exp2f(s.x); e.y = __builtin_amdgcn_exp2f(s.y);
    const f32x2 m = v * (q * e), r = v - m;
    f32x2 o; o.x = v.x < 0.f ? m.x : r.x; o.y = v.y < 0.f ? m.y : r.y; return o;
}

struct EpiF32 {
    static constexpr bool PERM = false, AFTER_DRAIN = false;
    float* C; int ldc; const float* bias;
    __device__ __forceinline__ void operator()(const f32x4 (&acc)[2][2][4][2], const Unit& u, int wr, int wc, int fr, int fq) const {
        const int row0 = u.pm * BM + wr * 64 + fr, col0 = u.pn * BM + wc * 32 + 4 * fq;
        f32x4 bv[2][2];
#pragma unroll
        for (int bj = 0; bj < 2; ++bj)
#pragma unroll
            for (int n = 0; n < 2; ++n) bv[bj][n] = bias ? *(const f32x4*)(bias + col0 + bj * HALF + n * 16) : (f32x4){0.f, 0.f, 0.f, 0.f};
#pragma unroll
        for (int ai = 0; ai < 2; ++ai)
#pragma unroll
            for (int m = 0; m < 4; ++m) { float* rowp = C + (size_t)(row0 + ai * HALF + m * 16) * ldc + col0;
#pragma unroll
                for (int bj = 0; bj < 2; ++bj)
#pragma unroll
                    for (int n = 0; n < 2; ++n) *(f32x4*)(rowp + bj * HALF + n * 16) = acc[ai][bj][m][n] + bv[bj][n]; }
    }
};
template <int ACT  > struct EpiBf16 {
    static constexpr bool PERM = true, AFTER_DRAIN = false;
    bf16_t* O; int ldc; const float* bias; int split_cols; size_t split_stride;
    __device__ __forceinline__ void operator()(const f32x4 (&acc)[2][2][4][2], const Unit& u, int wr, int wc, int fr, int fq) const {
        const int row0 = u.pm * BM + wr * 64 + fr; int colt = u.pn * BM; bf16_t* base = O;
        if (split_cols) { const int t = colt / split_cols; base += (size_t)t * split_stride; colt -= t * split_cols; }
        const int col0 = colt + wc * 32 + 8 * fq, bcol0 = u.pn * BM + wc * 32 + 8 * fq;
        f32x4 bv[2][2];
#pragma unroll
        for (int bj = 0; bj < 2; ++bj)
#pragma unroll
            for (int n = 0; n < 2; ++n) bv[bj][n] = bias ? *(const f32x4*)(bias + bcol0 + bj * HALF + 4 * n) : (f32x4){0.f, 0.f, 0.f, 0.f};
#pragma unroll
        for (int ai = 0; ai < 2; ++ai)
#pragma unroll
            for (int m = 0; m < 4; ++m) { bf16_t* rowp = base + (size_t)(row0 + ai * HALF + m * 16) * ldc + col0;
#pragma unroll
                for (int bj = 0; bj < 2; ++bj) { f32x4 v0 = acc[ai][bj][m][0] + bv[bj][0], v1 = acc[ai][bj][m][1] + bv[bj][1];
                    if (ACT == 1) { f32x2 a = gelu_pk((f32x2){v0[0], v0[1]}), b = gelu_pk((f32x2){v0[2], v0[3]}), c = gelu_pk((f32x2){v1[0], v1[1]}), d = gelu_pk((f32x2){v1[2], v1[3]});
                        v0 = (f32x4){a.x, a.y, b.x, b.y}; v1 = (f32x4){c.x, c.y, d.x, d.y}; }
                    if (ACT == 2) {
#pragma unroll
                        for (int j = 0; j < 4; ++j) { v0[j] = 0.5f * v0[j] * (1.0f + erff(v0[j] * 0.70710678f)); v1[j] = 0.5f * v1[j] * (1.0f + erff(v1[j] * 0.70710678f)); } }
                    u32x4 w; w.x = cvt_pk_bf16(v0[0], v0[1]); w.y = cvt_pk_bf16(v0[2], v0[3]); w.z = cvt_pk_bf16(v1[0], v1[1]); w.w = cvt_pk_bf16(v1[2], v1[3]);
                    *(u32x4*)(rowp + bj * HALF) = w; } }
    }
};

struct PanelStats {
    unsigned* xbuf;
    unsigned* cnt;
    unsigned* tmo;
    int ntn; float eps;
    unsigned code;
    __device__ __forceinline__ bool run(const f32x4 (&v)[2][2][4][2], const Unit& u, int wr, int wc, int fr, int fq, PG8_LAS unsigned char* lds, int wid, int lane) const {
        typedef float f32x2v __attribute__((ext_vector_type(2)));
        PG8_LAS f32x2v* P = (PG8_LAS f32x2v*)lds;
        PG8_LAS f32x2v* S = (PG8_LAS f32x2v*)(lds + 8192);
        PG8_LAS unsigned* flag = (PG8_LAS unsigned*)(lds + 8192 + 2048);
#pragma unroll
        for (int ai = 0; ai < 2; ++ai)
#pragma unroll
            for (int m = 0; m < 4; ++m) {
                float s = 0.f;
#pragma unroll
                for (int bj = 0; bj < 2; ++bj)
#pragma unroll
                    for (int n = 0; n < 2; ++n) { const f32x4 x = v[ai][bj][m][n]; s += (x[0] + x[1]) + (x[2] + x[3]); }
                s += __shfl_xor(s, 16); s += __shfl_xor(s, 32);
                const float mw = s * (1.0f / 64.0f); float q = 0.f;
#pragma unroll
                for (int bj = 0; bj < 2; ++bj)
#pragma unroll
                    for (int n = 0; n < 2; ++n) { const f32x4 d = v[ai][bj][m][n] - mw; q += (d[0] * d[0] + d[1] * d[1]) + (d[2] * d[2] + d[3] * d[3]); }
                q += __shfl_xor(q, 16); q += __shfl_xor(q, 32);
                if (fq == 0) P[(ai * HALF + wr * 64 + m * 16 + fr) * 4 + wc] = (f32x2v){mw, q};
            }
        asm volatile("s_waitcnt lgkmcnt(0)" ::: "memory"); __builtin_amdgcn_s_barrier(); asm volatile("" ::: "memory");
#if defined(BROKEN_NO_WAIT)
        if (blockIdx.x >= 64) { const long long t0 = clock64(); while (clock64() - t0 < 60000) __builtin_amdgcn_s_sleep(8); }
#endif
        const int row = wid * 32 + (lane & 31);
        if (lane < 32) {
            const f32x2v a = P[row * 4 + 0], b = P[row * 4 + 1], c = P[row * 4 + 2], d = P[row * 4 + 3];
            const float mt = (a.x + b.x + c.x + d.x) * 0.25f;
            const float da = a.x - mt, db = b.x - mt, dc = c.x - mt, dd = d.x - mt;
            const float m2 = (a.y + b.y) + (c.y + d.y) + 64.0f * ((da * da + db * db) + (dc * dc + dd * dd));
            unsigned long long* slot = (unsigned long long*)xbuf + ((size_t)(u.pm * BM + row) * 4 + u.pn);
            __hip_atomic_store(slot, ((unsigned long long)__float_as_uint(m2) << 32) | __float_as_uint(mt), __ATOMIC_RELAXED, __HIP_MEMORY_SCOPE_AGENT);
        }
        asm volatile("s_waitcnt vmcnt(0)" ::: "memory");
        if (lane == 0) __hip_atomic_fetch_add(cnt + 64 * u.pm, 1u, __ATOMIC_RELAXED, __HIP_MEMORY_SCOPE_AGENT);
        if (wid == 0) {
            bool dead = false; const unsigned long long t0 = __builtin_amdgcn_s_memrealtime(); const unsigned want = 8u * (unsigned)ntn;
            for (;;) {
#if defined(BROKEN_NO_WAIT)
                break;
#endif
                if ((unsigned)__builtin_amdgcn_readfirstlane(__hip_atomic_load(cnt + 64 * u.pm, __ATOMIC_RELAXED, __HIP_MEMORY_SCOPE_AGENT)) >= want) break;
                if (__builtin_amdgcn_s_memrealtime() - t0 > 2000000ull) {
                    if (lane == 0) { unsigned expect = 0u; __hip_atomic_compare_exchange_strong(tmo + 1, &expect, code | (unsigned)(u.pm & 0xff), __ATOMIC_RELAXED, __ATOMIC_RELAXED, __HIP_MEMORY_SCOPE_AGENT);
                                     __hip_atomic_store(tmo, 1u, __ATOMIC_RELAXED, __HIP_MEMORY_SCOPE_AGENT); }
                    dead = true; break; }
                __builtin_amdgcn_s_sleep(2);
            }
            __builtin_amdgcn_fence(__ATOMIC_ACQUIRE, "agent");
            if (lane == 0) flag[0] = dead ? 1u : 0u;
        }
        asm volatile("s_waitcnt vmcnt(0) lgkmcnt(0)" ::: "memory"); __builtin_amdgcn_s_barrier(); asm volatile("" ::: "memory");
        const bool bad = flag[0] != 0u;
        if (lane < 32) {
            const unsigned long long* slot = (const unsigned long long*)xbuf + (size_t)(u.pm * BM + row) * 4; float mt[4], m2[4]; float ms = 0.f;
#pragma unroll
            for (int t = 0; t < 4; ++t) { if (t < ntn) { const unsigned long long w = __hip_atomic_load(slot + t, __ATOMIC_RELAXED, __HIP_MEMORY_SCOPE_AGENT); mt[t] = __uint_as_float((unsigned)w); m2[t] = __uint_as_float((unsigned)(w >> 32)); } else { mt[t] = 0.f; m2[t] = 0.f; } ms += mt[t]; }
            const float mean = ms / (float)ntn; float q = 0.f;
#pragma unroll
            for (int t = 0; t < 4; ++t) if (t < ntn) { const float dm = mt[t] - mean; q += m2[t] + 256.0f * dm * dm; }
            S[row] = (f32x2v){mean, 1.0f / sqrtf(q / (256.0f * (float)ntn) + eps)};
        }
        asm volatile("s_waitcnt lgkmcnt(0)" ::: "memory"); __builtin_amdgcn_s_barrier(); asm volatile("" ::: "memory");
        return bad;
    }
};
struct EpiLnRes {
    static constexpr bool PERM = false, AFTER_DRAIN = true;
    const float* base; float* out; int ldc; const float* bias; PanelStats st; unsigned poison;
    __device__ __forceinline__ void refuse(size_t i0, size_t stride, int M, int N) const { const float q = __builtin_nanf(""); for (size_t i = i0; i < (size_t)M * N; i += stride) out[(i / N) * ldc + i % N] = q;
        if (i0 == 0) { unsigned expect = 0u; __hip_atomic_compare_exchange_strong(st.tmo + 1, &expect, 0x7f0u, __ATOMIC_RELAXED, __ATOMIC_RELAXED, __HIP_MEMORY_SCOPE_AGENT); __hip_atomic_store(st.tmo, 1u, __ATOMIC_RELAXED, __HIP_MEMORY_SCOPE_AGENT); } }
    __device__ __forceinline__ void fused(f32x4 (&acc)[2][2][4][2], const Unit& u, int wr, int wc, int fr, int fq, PG8_LAS unsigned char* lds, int wid, int lane) const {
        typedef float f32x2v __attribute__((ext_vector_type(2)));
        const PG8_LAS f32x2v* S = (const PG8_LAS f32x2v*)(lds + 8192);
        const int col0 = u.pn * BM + wc * 32 + 4 * fq;
#pragma unroll
        for (int bj = 0; bj < 2; ++bj)
#pragma unroll
            for (int n = 0; n < 2; ++n) { const f32x4 bv = bias ? *(const f32x4*)(bias + col0 + bj * HALF + n * 16) : (f32x4){0.f, 0.f, 0.f, 0.f};
#pragma unroll
                for (int ai = 0; ai < 2; ++ai)
#pragma unroll
                    for (int m = 0; m < 4; ++m) acc[ai][bj][m][n] += bv; }
        const bool bad = st.run(acc, u, wr, wc, fr, fq, lds, wid, lane) || poison != 0u;
        const float qnan = __builtin_nanf("");
#pragma unroll
        for (int ai = 0; ai < 2; ++ai)
#pragma unroll
            for (int m = 0; m < 4; ++m) { const int r = ai * HALF + wr * 64 + m * 16 + fr; const f32x2v sr = S[r]; const size_t off = (size_t)(u.pm * BM + r) * ldc + col0;
#pragma unroll
                for (int bj = 0; bj < 2; ++bj)
#pragma unroll
                    for (int n = 0; n < 2; ++n) { const f32x4 bs = *(const f32x4*)(base + off + bj * HALF + n * 16); f32x4 o = bs + (acc[ai][bj][m][n] - sr.x) * sr.y;
                        if (bad) o = (f32x4){qnan, qnan, qnan, qnan}; *(f32x4*)(out + off + bj * HALF + n * 16) = o; }
                asm volatile("" ::: "memory"); }
    }
};
struct EpiLnResLn {
    static constexpr bool PERM = false, AFTER_DRAIN = true;
    const float* base; float* out; bf16_t* xn; int ldc; const float* bias; PanelStats st1, st2; unsigned poison;
    __device__ __forceinline__ void refuse(size_t i0, size_t stride, int M, int N) const { const float q = __builtin_nanf(""); for (size_t i = i0; i < (size_t)M * N; i += stride) { const size_t o = (i / N) * ldc + i % N; out[o] = q; xn[o] = (bf16_t)0x7fc0u; }
        if (i0 == 0) { unsigned expect = 0u; __hip_atomic_compare_exchange_strong(st1.tmo + 1, &expect, 0x7f0u, __ATOMIC_RELAXED, __ATOMIC_RELAXED, __HIP_MEMORY_SCOPE_AGENT); __hip_atomic_store(st1.tmo, 1u, __ATOMIC_RELAXED, __HIP_MEMORY_SCOPE_AGENT); } }
    __device__ __forceinline__ void fused(f32x4 (&acc)[2][2][4][2], const Unit& u, int wr, int wc, int fr, int fq, PG8_LAS unsigned char* lds, int wid, int lane) const {
        typedef float f32x2v __attribute__((ext_vector_type(2))); typedef unsigned u32x2v __attribute__((ext_vector_type(2)));
        const PG8_LAS f32x2v* S = (const PG8_LAS f32x2v*)(lds + 8192);
        const int col0 = u.pn * BM + wc * 32 + 4 * fq;
#pragma unroll
        for (int bj = 0; bj < 2; ++bj)
#pragma unroll
            for (int n = 0; n < 2; ++n) { const f32x4 bv = bias ? *(const f32x4*)(bias + col0 + bj * HALF + n * 16) : (f32x4){0.f, 0.f, 0.f, 0.f};
#pragma unroll
                for (int ai = 0; ai < 2; ++ai)
#pragma unroll
                    for (int m = 0; m < 4; ++m) acc[ai][bj][m][n] += bv; }
        bool bad = st1.run(acc, u, wr, wc, fr, fq, lds, wid, lane) || poison != 0u;
        const float qnan = __builtin_nanf("");
#pragma unroll
        for (int ai = 0; ai < 2; ++ai)
#pragma unroll
            for (int m = 0; m < 4; ++m) { const int r = ai * HALF + wr * 64 + m * 16 + fr; const f32x2v sr = S[r]; const size_t off = (size_t)(u.pm * BM + r) * ldc + col0;
#pragma unroll
                for (int bj = 0; bj < 2; ++bj)
#pragma unroll
                    for (int n = 0; n < 2; ++n) { const f32x4 bs = *(const f32x4*)(base + off + bj * HALF + n * 16); acc[ai][bj][m][n] = bs + (acc[ai][bj][m][n] - sr.x) * sr.y; }
                asm volatile("" : "+v"(acc[ai][0][m][0]), "+v"(acc[ai][0][m][1]), "+v"(acc[ai][1][m][0]), "+v"(acc[ai][1][m][1]));
                if (m & 1) asm volatile("" ::: "memory"); }
        const bool bad1 = bad;
        bad = st2.run(acc, u, wr, wc, fr, fq, lds, wid, lane) || bad;
#pragma unroll
        for (int ai = 0; ai < 2; ++ai)
#pragma unroll
            for (int m = 0; m < 4; ++m) { const int r = ai * HALF + wr * 64 + m * 16 + fr; const f32x2v sr = S[r]; const size_t off = (size_t)(u.pm * BM + r) * ldc + col0;
#pragma unroll
                for (int bj = 0; bj < 2; ++bj)
#pragma unroll
                    for (int n = 0; n < 2; ++n) { const f32x4 x1 = acc[ai][bj][m][n]; *(f32x4*)(out + off + bj * HALF + n * 16) = bad1 ? (f32x4){qnan, qnan, qnan, qnan} : x1;
                        const f32x4 o = (x1 - sr.x) * sr.y; u32x2v w; w.x = cvt_pk_bf16(o[0], o[1]); w.y = cvt_pk_bf16(o[2], o[3]);
                        if (bad) { w.x = 0x7fc07fc0u; w.y = 0x7fc07fc0u; } *(u32x2v*)(xn + off + bj * HALF + n * 16) = w; }
                asm volatile("" ::: "memory"); }
    }
};

template <class Epi, class Sched, bool STAMP = false>
__device__ __forceinline__ void gemm_phase(PG8_LAS unsigned char* lds, const Gemm g, const Sched& S, const Epi& E, unsigned long long* stamps) {
    int tid_raw_ = threadIdx.x; asm volatile("" : "+v"(tid_raw_));
    const int tid = tid_raw_, wid = __builtin_amdgcn_readfirstlane(tid >> 6), lane = tid & 63, wr = wid >> 2, wc = wid & 3, fr = lane & 15, fq = lane >> 4;
    const int K = g.K, nt = K / BK;
    int ts_lo = 0, ts_hi = 0, nts = 0; const unsigned long long rt_entry = STAMP ? (unsigned long long)wall_clock64() : 0ull;
#define PG8_STAMP() do { if (STAMP && wid == 0 && nts < 64) { const unsigned long long _c = (unsigned long long)clock64(); \
        ts_lo = (lane == nts) ? (int)(unsigned)_c : ts_lo; ts_hi = (lane == nts) ? (int)(unsigned)(_c >> 32) : ts_hi; ++nts; } } while (0)
    PG8_STAMP();
    unsigned voffA[2], voffB[2];
#pragma unroll
    for (int i = 0; i < 2; ++i) { int R, C; stage_rc(tid * 16 + i * 8192, R, C); const int Rb = Epi::PERM ? ((R & ~31) + perm32(R & 31)) : R;
        voffA[i] = (unsigned)(R * K + C) * 2u; voffB[i] = (unsigned)(Rb * K + C) * 2u; }
    const size_t kstep = (size_t)(BK * 2);
    const size_t hstep = (size_t)HALF * K * 2;
    const size_t tstep = 2 * hstep;
    const unsigned ldsw = (unsigned)wid * 1024u;
    const int aoff = lds_byte(wr * 64 + fr, fq * 8), boff = lds_byte(wc * 32 + fr, fq * 8);
#define PG8_SA(b, h) (((b) * 2 + (h)) * HTB)
#define PG8_SB(b, h) ((4 + (b) * 2 + (h)) * HTB)
#define PG8_STAGE(bufoff, gbase, voff) do { _Pragma("unroll") for (int _i = 0; _i < 2; ++_i) \
        __builtin_amdgcn_global_load_lds((const unsigned*)((const char*)(gbase) + (voff)[_i]), (PG8_LAS unsigned*)(lds + (bufoff) + ldsw + _i * 8192), 16, 0, 0); } while (0)
#define PG8_LDA(dst, b, h) do { _Pragma("unroll") for (int m = 0; m < 4; ++m) _Pragma("unroll") for (int k = 0; k < 2; ++k) dst[m][k] = *(const PG8_LAS bf16x8*)(lds + PG8_SA(b, h) + aoff + m * 2048 + k * 1024); } while (0)
#define PG8_LDB(dst, b, h) do { _Pragma("unroll") for (int n = 0; n < 2; ++n) _Pragma("unroll") for (int k = 0; k < 2; ++k) dst[n][k] = *(const PG8_LAS bf16x8*)(lds + PG8_SB(b, h) + boff + n * 2048 + k * 1024); } while (0)
#define PG8_MMA(ai, bj, At, Bt) do { __builtin_amdgcn_s_setprio(1); _Pragma("unroll") for (int m = 0; m < 4; ++m) _Pragma("unroll") for (int n = 0; n < 2; ++n) _Pragma("unroll") for (int k = 0; k < 2; ++k) \
        acc[ai][bj][m][n] = __builtin_amdgcn_mfma_f32_16x16x32_bf16(Bt[n][k], At[m][k], acc[ai][bj][m][n], 0, 0, 0); __builtin_amdgcn_s_setprio(0); } while (0)
#define PG8_WAIT_V(n) asm volatile("s_waitcnt vmcnt(" #n ")" ::: "memory")
#define PG8_WAIT_L(n) asm volatile("s_waitcnt lgkmcnt(" #n ")" ::: "memory")
#define PG8_BAR __builtin_amdgcn_s_barrier()
#define PG8_SCHED __builtin_amdgcn_sched_barrier(0)
    Unit cur, nxt; int ui = 0;
    if (!S.next(0, cur)) return;
    f32x4 acc[2][2][4][2];
#pragma unroll
    for (int a = 0; a < 2; ++a)
#pragma unroll
        for (int b = 0; b < 2; ++b)
#pragma unroll
            for (int m = 0; m < 4; ++m)
#pragma unroll
                for (int n = 0; n < 2; ++n) acc[a][b][m][n] = (f32x4){0.f, 0.f, 0.f, 0.f};
    bf16x8 At[4][2], B0[2][2], B1[2][2];
    const char* cA = (const char*)g.A + (size_t)cur.pm * tstep; const char* cB = (const char*)g.Bt + (size_t)cur.pn * tstep;
    S.a_ready(cur);
    PG8_STAGE(PG8_SB(0, 0), cB, voffB); PG8_STAGE(PG8_SA(0, 0), cA, voffA); PG8_STAGE(PG8_SB(0, 1), cB + hstep, voffB); PG8_STAGE(PG8_SA(0, 1), cA + hstep, voffA);
    if (wr == 1) PG8_BAR;
    PG8_WAIT_V(4); PG8_BAR;
    PG8_STAGE(PG8_SB(1, 0), cB + kstep, voffB); PG8_STAGE(PG8_SA(1, 0), cA + kstep, voffA); PG8_STAGE(PG8_SB(1, 1), cB + hstep + kstep, voffB);
    PG8_WAIT_V(6); PG8_BAR;
    PG8_STAMP();
    for (;;) {
        const bool has_next = S.next(ui + 1, nxt);
        const char* nA = has_next ? (const char*)g.A + (size_t)nxt.pm * tstep : cA; const char* nB = has_next ? (const char*)g.Bt + (size_t)nxt.pn * tstep : cB;
        for (int t = 0; t < nt; t += 2) {
            const bool last = (t == nt - 2);
            const char* a1 = cA + (size_t)(t + 1) * kstep;
            const char* a2 = last ? nA : cA + (size_t)(t + 2) * kstep; const char* b2 = last ? nB : cB + (size_t)(t + 2) * kstep;
            const char* a3 = a2 + kstep; const char* b3 = b2 + kstep;
            if (last && has_next) S.a_ready(nxt);
            PG8_LDB(B0, 0, 0); PG8_SCHED; PG8_LDA(At, 0, 0); PG8_STAGE(PG8_SA(1, 1), a1 + hstep, voffA);
            PG8_WAIT_L(8); PG8_BAR; PG8_WAIT_L(0); PG8_MMA(0, 0, At, B0); PG8_BAR; PG8_SCHED;
            PG8_LDB(B1, 0, 1); PG8_STAGE(PG8_SB(0, 0), b2, voffB);
            PG8_BAR; PG8_WAIT_L(0); PG8_MMA(0, 1, At, B1); PG8_BAR;
            PG8_LDA(At, 0, 1); PG8_STAGE(PG8_SA(0, 0), a2, voffA);
            PG8_BAR; PG8_WAIT_L(0); PG8_MMA(1, 0, At, B0); PG8_BAR; PG8_SCHED;
            PG8_STAGE(PG8_SB(0, 1), b2 + hstep, voffB);
            PG8_WAIT_V(6); PG8_BAR; PG8_MMA(1, 1, At, B1); PG8_BAR;
            PG8_LDB(B0, 1, 0); PG8_SCHED; PG8_LDA(At, 1, 0); PG8_STAGE(PG8_SA(0, 1), a2 + hstep, voffA);
            PG8_WAIT_L(8); PG8_BAR; PG8_WAIT_L(0); PG8_MMA(0, 0, At, B0); PG8_BAR; PG8_SCHED;
            PG8_LDB(B1, 1, 1); PG8_STAGE(PG8_SB(1, 0), b3, voffB);
            PG8_BAR; PG8_WAIT_L(0); PG8_MMA(0, 1, At, B1); PG8_BAR;
            PG8_LDA(At, 1, 1); PG8_STAGE(PG8_SA(1, 0), a3, voffA);
            PG8_BAR; PG8_WAIT_L(0); PG8_MMA(1, 0, At, B0); PG8_BAR; PG8_SCHED;
            PG8_STAGE(PG8_SB(1, 1), b3 + hstep, voffB);
            PG8_WAIT_V(6); PG8_BAR; PG8_MMA(1, 1, At, B1); PG8_BAR;
        }
        PG8_STAMP();
        if constexpr (!Epi::AFTER_DRAIN) { E(acc, cur, wr, wc, fr, fq); S.done(cur); }
        PG8_STAMP();
        if (!has_next) break;
#pragma unroll
        for (int a = 0; a < 2; ++a)
#pragma unroll
            for (int b = 0; b < 2; ++b)
#pragma unroll
                for (int m = 0; m < 4; ++m)
#pragma unroll
                    for (int n = 0; n < 2; ++n) acc[a][b][m][n] = (f32x4){0.f, 0.f, 0.f, 0.f};
        cur = nxt; cA = nA; cB = nB; ++ui;
    }
    PG8_WAIT_V(0);
    if (wr == 0) PG8_BAR;
    PG8_BAR;
    if constexpr (Epi::AFTER_DRAIN) { E.fused(acc, cur, wr, wc, fr, fq, lds, wid, lane); S.done(cur); }
    PG8_STAMP();
    if (STAMP && wid == 0) { stamps[lane] = lane < nts ? (((unsigned long long)(unsigned)ts_hi << 32) | (unsigned)ts_lo) : 0ull;
        if (lane == 62) stamps[62] = rt_entry; if (lane == 63) stamps[63] = (unsigned long long)wall_clock64(); }
#undef PG8_STAMP
#undef PG8_SA
#undef PG8_SB
#undef PG8_STAGE
#undef PG8_LDA
#undef PG8_LDB
#undef PG8_MMA
#undef PG8_WAIT_V
#undef PG8_WAIT_L
#undef PG8_BAR
#undef PG8_SCHED
}
}

#ifndef ONE_LAUNCH
#define ONE_LAUNCH 0
#endif
constexpr int NWAVES = 8, NTHR = 512;
constexpr int M_TOK = 49152, DM = 1024, SEQL = 2048, NSEQ = 24;
constexpr int CH_SEQ = 8, CH_ROWS = CH_SEQ * SEQL, NCHUNK = 3;
constexpr int QKV_N = 9216, NEXP = 16384, PQ_N = 2048, PLE_K = 256;
constexpr float DN_ALPHA = 1.681792830507429f, LN_EPS = 1e-5f;
constexpr float QSCALE = 0.12751743082459868f;
constexpr int N_PHASES = 1 + 2 * (9 + 6) + 2 * (2 + 6);

constexpr size_t MiB = 1u << 20;
constexpr size_t WS_CTL = 0, CTL_ZERO_BYTES = 65536;
constexpr size_t WS_WQKV = 1 * MiB, WS_WO = 37 * MiB, WS_WCIN = 41 * MiB, WS_WCOUT = 53 * MiB, WS_WPQ = 57 * MiB, WS_SK = 73 * MiB, WS_WPP = 75 * MiB, WS_WG = 77 * MiB;
constexpr size_t WS_ROPE = 85 * MiB, WS_U = 86 * MiB, WS_V = 214 * MiB, WS_PB = 342 * MiB, WS_A1 = 438 * MiB, WS_A2 = 534 * MiB, WS_R1 = 630 * MiB, WS_R2 = 918 * MiB, WS_END = 1016 * MiB;
constexpr size_t R1_H = 0, R1_GB = 96 * MiB, R1_QP = 0, R1_PP = 192 * MiB;
constexpr size_t R2_OG = 0, R2_LSE = 96 * MiB, R2_SEL = 0;
constexpr int CW_BAR = 1024;

constexpr int SCR_BYTES = 152064, MISC_OFF = SCR_BYTES, LDS_BYTES = SCR_BYTES + 512;

#define GAS __attribute__((address_space(1)))
#define LAS __attribute__((address_space(3)))
typedef unsigned short bf16;
typedef unsigned v4u __attribute__((ext_vector_type(4)));
typedef unsigned v2u __attribute__((ext_vector_type(2)));
typedef float f32x4 __attribute__((ext_vector_type(4)));
typedef float f32x2 __attribute__((ext_vector_type(2)));
typedef short bf16x8 __attribute__((ext_vector_type(8)));
typedef __bf16 bf16x2_t __attribute__((ext_vector_type(2)));

__device__ __forceinline__ unsigned f2bf(float f) { unsigned u = __builtin_bit_cast(unsigned, f); return (u + 0x7fffu + ((u >> 16) & 1u)) >> 16; }
__device__ __forceinline__ unsigned pk2(float lo, float hi) { return f2bf(lo) | (f2bf(hi) << 16); }
__device__ __forceinline__ float bflo(unsigned w) { return __builtin_bit_cast(float, w << 16); }
__device__ __forceinline__ float bfhi(unsigned w) { return __builtin_bit_cast(float, w & 0xffff0000u); }
__device__ __forceinline__ float dot2bf(unsigned a, unsigned b, float acc) { return __builtin_amdgcn_fdot2_f32_bf16(__builtin_bit_cast(bf16x2_t, a), __builtin_bit_cast(bf16x2_t, b), acc, false); }
__device__ __forceinline__ float wave_sum(float v) {
#pragma unroll
    for (int o = 1; o < 64; o <<= 1) v += __shfl_xor(v, o);
    return v;
}
__device__ __forceinline__ float wave_max(float v) {
#pragma unroll
    for (int o = 1; o < 64; o <<= 1) v = fmaxf(v, __shfl_xor(v, o));
    return v;
}

#define XB_TMO      128
#define XB_XCNT(j)  (256  + 64 * (j))
#define XB_XSUB(j)  (1280 + 64 * (j))
#define XB_XGEN(j)  (2304 + 64 * (j))
#define XB_TOP      3328
#define XB_TOPGEN   3392
#define XCD_BAR_WORDS 3456
#define XB_SPIN_CAP (1u << 21)
__device__ __forceinline__ unsigned xb_ld(unsigned* p)              { return __hip_atomic_load(p, __ATOMIC_RELAXED, __HIP_MEMORY_SCOPE_AGENT); }
__device__ __forceinline__ unsigned xb_add(unsigned* p, unsigned v) { return __hip_atomic_fetch_add(p, v, __ATOMIC_RELAXED, __HIP_MEMORY_SCOPE_AGENT); }
__device__ __forceinline__ unsigned xb_xcc_id() { return (unsigned)__builtin_amdgcn_s_getreg((3 << 11) | 20) & 0xFu; }
#define XB_SPIN(cond, bar) do { unsigned _sp = 0; while (cond) { __builtin_amdgcn_s_sleep(1); \
    if ((++_sp & 255u) == 0u) { if (xb_ld(&(bar)[XB_TMO])) break; if (_sp > XB_SPIN_CAP) { atomicAdd(&(bar)[XB_TMO], 1u); break; } } } } while (0)
struct XcdBarrier { unsigned* bar; unsigned x; volatile LAS unsigned* st; };
__device__ __forceinline__ XcdBarrier xcd_barrier_post(unsigned* bar, volatile LAS unsigned* st) {
    XcdBarrier b; b.bar = bar; b.x = xb_xcc_id(); b.st = st;
    if (threadIdx.x == 0) (void)xb_add(&bar[XB_XCNT(b.x)], 1u);
    return b;
}
__device__ __forceinline__ void xcd_barrier_complete(unsigned* bar, unsigned x, unsigned& nloc, unsigned& nx) {
    const unsigned G = gridDim.x * gridDim.y * gridDim.z;
    unsigned sum, cnt, mine, sp = 0u;
    for (;;) {
        sum = 0u; cnt = 0u; mine = 0u;
#pragma unroll
        for (unsigned j = 0; j < 16; ++j) { const unsigned c = xb_ld(&bar[XB_XCNT(j)]); sum += c; cnt += (c > 0u) ? 1u : 0u; mine = (j == x) ? c : mine; }
        if (sum == G) break;
        __builtin_amdgcn_s_sleep(1);
        if ((++sp & 255u) == 0u) { if (xb_ld(&bar[XB_TMO])) break; if (sp > XB_SPIN_CAP) { atomicAdd(&bar[XB_TMO], 1u); break; } }
    }
    nloc = mine > 0u ? mine : 1u; nx = cnt > 0u ? cnt : 1u;
}
__device__ __forceinline__ void xcd_barrier(const XcdBarrier& b) {
    asm volatile("s_waitcnt vmcnt(0)" ::: "memory");
    __syncthreads();
    if (threadIdx.x == 0) {
        unsigned* bar = b.bar;
        __builtin_amdgcn_s_waitcnt(0);
        unsigned nloc = b.st[0], nx = b.st[1];
        if (nloc == 0u) { xcd_barrier_complete(bar, b.x, nloc, nx); b.st[0] = nloc; b.st[1] = nx; }
        const unsigned old = xb_add(&bar[XB_XSUB(b.x)], 1u);
        const unsigned gen = old / nloc;
        if (old + 1u == (gen + 1u) * nloc) {
            __builtin_amdgcn_fence(__ATOMIC_RELEASE, "agent");
            asm volatile("s_waitcnt vmcnt(0)" ::: "memory");
            const unsigned og = xb_add(&bar[XB_TOP], 1u);
            const unsigned tg = og / nx;
            if (og + 1u == (tg + 1u) * nx) xb_add(&bar[XB_TOPGEN], 1u);
            else XB_SPIN(xb_ld(&bar[XB_TOPGEN]) == tg, bar);
            __builtin_amdgcn_fence(__ATOMIC_ACQUIRE, "agent");
            xb_add(&bar[XB_XGEN(b.x)], 1u);
            asm volatile("s_waitcnt vmcnt(0)" ::: "memory");
        } else {
            XB_SPIN(xb_ld(&bar[XB_XGEN(b.x)]) == gen, bar);
            __builtin_amdgcn_fence(__ATOMIC_ACQUIRE, "agent");
            asm volatile("s_waitcnt vmcnt(0)" ::: "memory");
        }
    }
    __syncthreads();
}

struct EpiResid {
    static constexpr bool PERM = false, AFTER_DRAIN = false;
    float* X;
    __device__ __forceinline__ void operator()(const f32x4 (&acc)[2][2][4][2], const pg8::Unit& u, int wr, int wc, int fr, int fq) const {
        const int row0 = u.pm * 256 + wr * 64 + fr, col0 = u.pn * 256 + wc * 32 + 4 * fq;
#pragma unroll
        for (int ai = 0; ai < 2; ++ai)
#pragma unroll
            for (int m = 0; m < 4; ++m) { float* rowp = X + (size_t)(row0 + ai * 128 + m * 16) * DM + col0;
#pragma unroll
                for (int bj = 0; bj < 2; ++bj)
#pragma unroll
                    for (int n = 0; n < 2; ++n) { f32x4* p = (f32x4*)(rowp + bj * 128 + n * 16); const f32x4 x = *p; *p = x * DN_ALPHA + acc[ai][bj][m][n]; } }
    }
};
struct EpiGate {
    static constexpr bool PERM = false, AFTER_DRAIN = false;
    float* X; const bf16* PP; bf16* XB;
    __device__ __forceinline__ void operator()(const f32x4 (&acc)[2][2][4][2], const pg8::Unit& u, int wr, int wc, int fr, int fq) const {
        const int row0 = u.pm * 256 + wr * 64 + fr, col0 = u.pn * 256 + wc * 32 + 4 * fq;
#pragma unroll
        for (int ai = 0; ai < 2; ++ai)
#pragma unroll
            for (int m = 0; m < 4; ++m) { const size_t ro = (size_t)(row0 + ai * 128 + m * 16) * DM + col0;
#pragma unroll
                for (int bj = 0; bj < 2; ++bj)
#pragma unroll
                    for (int n = 0; n < 2; ++n) { const size_t o = ro + bj * 128 + n * 16; const f32x4 x = *(const f32x4*)(X + o); const v2u pw = *(const v2u*)(PP + o); const f32x4 a = acc[ai][bj][m][n];
                        f32x4 r;
                        r.x = x.x + bflo(pw.x) / (1.0f + __expf(-a.x)); r.y = x.y + bfhi(pw.x) / (1.0f + __expf(-a.y));
                        r.z = x.z + bflo(pw.y) / (1.0f + __expf(-a.z)); r.w = x.w + bfhi(pw.y) / (1.0f + __expf(-a.w));
                        *(f32x4*)(X + o) = r; v2u w; w.x = pk2(r.x, r.y); w.y = pk2(r.z, r.w); *(v2u*)(XB + o) = w; } }
    }
};
struct EpiCin {
    static constexpr bool PERM = true, AFTER_DRAIN = false;
    bf16* H; bf16* GB;
    __device__ __forceinline__ void operator()(const f32x4 (&acc)[2][2][4][2], const pg8::Unit& u, int wr, int wc, int fr, int fq) const {
        const int row0 = u.pm * 256 + wr * 64 + fr;
        if (u.pn < 8) {
            const int c0 = u.pn * 128 + wc * 32 + 8 * fq;
#pragma unroll
            for (int ai = 0; ai < 2; ++ai)
#pragma unroll
                for (int m = 0; m < 4; ++m) { const f32x4 g0 = acc[ai][0][m][0], g1 = acc[ai][0][m][1], x0 = acc[ai][1][m][0], x1 = acc[ai][1][m][1];
                    v4u w; w.x = pk2(g0.x * x0.x, g0.y * x0.y); w.y = pk2(g0.z * x0.z, g0.w * x0.w); w.z = pk2(g1.x * x1.x, g1.y * x1.y); w.w = pk2(g1.z * x1.z, g1.w * x1.w);
                    *(v4u*)(H + (size_t)(row0 + ai * 128 + m * 16) * DM + c0) = w; }
        } else {
            const int c0 = (u.pn - 8) * 256 + wc * 32 + 8 * fq;
#pragma unroll
            for (int ai = 0; ai < 2; ++ai)
#pragma unroll
                for (int m = 0; m < 4; ++m)
#pragma unroll
                    for (int bj = 0; bj < 2; ++bj) { const f32x4 v0 = acc[ai][bj][m][0], v1 = acc[ai][bj][m][1];
                        v4u w; w.x = pk2(v0.x, v0.y); w.y = pk2(v0.z, v0.w); w.z = pk2(v1.x, v1.y); w.w = pk2(v1.z, v1.w);
                        *(v4u*)(GB + (size_t)(row0 + ai * 128 + m * 16) * DM + c0 + bj * 128) = w; }
        }
    }
};
struct EpiQKV {
    static constexpr bool PERM = true, AFTER_DRAIN = false;
    bf16* P; const f32x2* rope;
    __device__ __forceinline__ void operator()(const f32x4 (&acc)[2][2][4][2], const pg8::Unit& u, int wr, int wc, int fr, int fq) const {
        const int g = u.pn / 12, t = (u.pn % 12) >> 2, hp = u.pn & 3;
        const int sq = u.pm >> 3;
        const int tok0 = (u.pm & 7) * 256 + wr * 64 + fr;
        const int d0 = wc * 32 + 8 * fq;
        const bool rot = (t < 2) && (wc == 0);
        const float sc = (t == 0) ? QSCALE : 1.0f;
#pragma unroll
        for (int ai = 0; ai < 2; ++ai)
#pragma unroll
            for (int m = 0; m < 4; ++m) {
                const int tok = tok0 + ai * 128 + m * 16;
                f32x4 cs[4];
                if (rot) {
                    const f32x4* rp = (const f32x4*)(rope + tok * 16 + 8 * (fq & 1));
#pragma unroll
                    for (int q = 0; q < 4; ++q) cs[q] = rp[q];
                }
#pragma unroll
                for (int bj = 0; bj < 2; ++bj) {
                    float v[8];
#pragma unroll
                    for (int n = 0; n < 2; ++n) { const f32x4 a = acc[ai][bj][m][n]; v[4 * n] = a.x; v[4 * n + 1] = a.y; v[4 * n + 2] = a.z; v[4 * n + 3] = a.w; }
                    if (rot) {
#pragma unroll
                        for (int e = 0; e < 8; ++e) { const float pr = __shfl_xor(v[e], 32); const f32x4 c2 = cs[e >> 1]; const float co = (e & 1) ? c2.z : c2.x, si = (e & 1) ? c2.w : c2.y;
                            v[e] = (fq < 2) ? (v[e] * co - pr * si) : (v[e] * co + pr * si); }
                    }
                    const int h = 2 * hp + bj;
                    const size_t plane = (size_t)(((sq * 3 + g) * 3 + t) * 8 + h);
                    v4u w; w.x = pk2(v[0] * sc, v[1] * sc); w.y = pk2(v[2] * sc, v[3] * sc); w.z = pk2(v[4] * sc, v[5] * sc); w.w = pk2(v[6] * sc, v[7] * sc);
                    *(v4u*)(P + (plane * SEQL + tok) * 128 + d0) = w;
                }
            }
    }
};

struct Args { const float* in[19]; float* out; unsigned char* ws; float inv_freq[16]; int ph_lo, ph_hi; };

__device__ __forceinline__ void transpose_item(const float* W, int K, int N, bf16* WT, int k0, int n0, int drow0, LAS float* scr, int lane) {
#pragma unroll 8
    for (int i = 0; i < 32; ++i) { const int kk = 2 * i + (lane >> 5); scr[kk * 33 + (lane & 31)] = W[(size_t)(k0 + kk) * N + n0 + (lane & 31)]; }
    asm volatile("s_waitcnt lgkmcnt(0)" ::: "memory");
    const int c = lane & 7;
#pragma unroll
    for (int j = 0; j < 4; ++j) { const int n = (lane >> 3) + 8 * j; const LAS float* s = scr + (8 * c) * 33 + n;
        v4u o; o.x = pk2(s[0 * 33], s[1 * 33]); o.y = pk2(s[2 * 33], s[3 * 33]); o.z = pk2(s[4 * 33], s[5 * 33]); o.w = pk2(s[6 * 33], s[7 * 33]);
        *(v4u*)(WT + (size_t)(drow0 + n) * K + k0 + 8 * c) = o; }
    asm volatile("s_waitcnt lgkmcnt(0)" ::: "memory");
}
__device__ __forceinline__ void cvt_range(const float* src, bf16* dst, size_t n8, size_t g0, size_t gs) {
    for (size_t i = g0; i < n8; i += gs) { const f32x4 a = ((const f32x4*)src)[2 * i], b = ((const f32x4*)src)[2 * i + 1];
        v4u o; o.x = pk2(a.x, a.y); o.y = pk2(a.z, a.w); o.z = pk2(b.x, b.y); o.w = pk2(b.z, b.w); ((v4u*)dst)[i] = o; }
}
__device__ __forceinline__ void cvt_copy_range(const float* src, bf16* dst, float* cpy, size_t n8, size_t g0, size_t gs) {
    for (size_t i = g0; i < n8; i += gs) { const f32x4 a = ((const f32x4*)src)[2 * i], b = ((const f32x4*)src)[2 * i + 1];
        v4u o; o.x = pk2(a.x, a.y); o.y = pk2(a.z, a.w); o.z = pk2(b.x, b.y); o.w = pk2(b.z, b.w); ((v4u*)dst)[i] = o; ((f32x4*)cpy)[2 * i] = a; ((f32x4*)cpy)[2 * i + 1] = b; }
}
__device__ __forceinline__ void sincos_d(double x, double& s, double& c) {
    const double k = rint(x * 0.15915494309189533576888376337251); const double r = x - k * 6.283185307179586476925286766559; const double r2 = r * r;
    double sp = 1.0, cp = 1.0;
    for (int n = 14; n >= 1; --n) { sp = 1.0 - sp * r2 / ((2.0 * n) * (2.0 * n + 1.0)); cp = 1.0 - cp * r2 / ((2.0 * n - 1.0) * (2.0 * n)); }
    s = r * sp; c = cp;
}
__device__ __forceinline__ void prologue(const Args& a, unsigned char* ws, LAS unsigned char* lds, int tid, int lane, int wave, int bid, int G) {
    const int gw = bid * NWAVES + wave, NGW = G * NWAVES;
    LAS float* scr = (LAS float*)(lds + wave * 16384);
    for (int mi = 0; mi < 20; ++mi) {
        const float* W; bf16* WT; int K = 1024, N = 1024, mode = 0;
        if (mi < 2)       { W = a.in[4] + (size_t)mi * 1024 * QKV_N;          WT = (bf16*)(ws + WS_WQKV) + (size_t)mi * QKV_N * 1024; N = QKV_N; }
        else if (mi < 4)  { W = a.in[5] + (size_t)(mi - 2) * 1024 * 1024;    WT = (bf16*)(ws + WS_WO) + (size_t)(mi - 2) * 1024 * 1024; }
        else if (mi < 6)  { W = a.in[6] + (size_t)(mi - 4) * 1024 * 3072;    WT = (bf16*)(ws + WS_WCIN) + (size_t)(mi - 4) * 3072 * 1024; N = 3072; mode = 1; }
        else if (mi < 8)  { W = a.in[8] + (size_t)(mi - 6) * 1024 * 1024;    WT = (bf16*)(ws + WS_WCOUT) + (size_t)(mi - 6) * 1024 * 1024; }
        else if (mi < 12) { W = a.in[9] + (size_t)(mi - 8) * 1024 * PQ_N;    WT = (bf16*)(ws + WS_WPQ) + (size_t)(mi - 8) * PQ_N * 1024; N = PQ_N; }
        else if (mi < 16) { W = a.in[17] + (size_t)(mi - 12) * PLE_K * 1024; WT = (bf16*)(ws + WS_WPP) + (size_t)(mi - 12) * 1024 * PLE_K; K = PLE_K; }
        else              { W = a.in[18] + (size_t)(mi - 16) * 1024 * 1024;  WT = (bf16*)(ws + WS_WG) + (size_t)(mi - 16) * 1024 * 1024; }
        const int nblk = N / 32, nitems = (K / 64) * nblk;
        for (int it = gw; it < nitems; it += NGW) {
            const int kb = it / nblk, nb = it % nblk, n0 = 32 * nb;
            int drow0 = n0;
            if (mode == 1) {
                const int part = n0 >> 10, c = n0 & 1023;
                drow0 = (part == 0) ? (2048 + c) : (256 * (c >> 7) + (c & 127) + (part == 2 ? 128 : 0));
            }
            transpose_item(W, K, N, WT, 64 * kb, n0, drow0, scr, lane);
        }
    }
    const size_t g0 = (size_t)bid * NTHR + tid, gs = (size_t)G * NTHR;
    cvt_range(a.in[10], (bf16*)(ws + WS_SK), (size_t)4 * 8 * 2 * 128 * 128 / 8, g0, gs);
    cvt_range(a.in[11], (bf16*)(ws + WS_U), (size_t)4 * NEXP * 1024 / 8, g0, gs);
    cvt_range(a.in[12], (bf16*)(ws + WS_V), (size_t)4 * NEXP * 1024 / 8, g0, gs);
    for (int i = 0; i < 4; ++i) {
        cvt_range(a.in[2] + (size_t)i * 16384 * PLE_K, (bf16*)(ws + WS_PB) + (size_t)i * M_TOK * PLE_K, (size_t)16384 * PLE_K / 8, g0, gs);
        cvt_range(a.in[3] + (size_t)i * 32768 * PLE_K, (bf16*)(ws + WS_PB) + (size_t)i * M_TOK * PLE_K + (size_t)16384 * PLE_K, (size_t)32768 * PLE_K / 8, g0, gs);
    }
    cvt_copy_range(a.in[0], (bf16*)(ws + WS_A2), a.out, (size_t)16384 * DM / 8, g0, gs);
    cvt_copy_range(a.in[1], (bf16*)(ws + WS_A2) + (size_t)16384 * DM, a.out + (size_t)16384 * DM, (size_t)32768 * DM / 8, g0, gs);
    for (size_t e = g0; e < (size_t)SEQL * 16; e += gs) {
        const int pos = (int)(e >> 4), i = (int)(e & 15);
        const float ang = (float)pos * a.inv_freq[i];
        double s, c; sincos_d((double)ang, s, c);
        f32x2 o; o.x = (float)c; o.y = (float)s; ((f32x2*)(ws + WS_ROPE))[e] = o;
    }
}

__device__ __forceinline__ void ln_rows(float* X, bf16* XB, const float* gain, const float* bias, int lane, int gw, int NGW) {
    f32x4 gv[4], bv[4];
#pragma unroll
    for (int j = 0; j < 4; ++j) { gv[j] = ((const f32x4*)gain)[64 * j + lane]; bv[j] = ((const f32x4*)bias)[64 * j + lane]; }
    for (int r = gw; r < M_TOK; r += NGW) {
        f32x4* xr = (f32x4*)(X + (size_t)r * DM) + lane;
        f32x4 v[4]; float s = 0.f;
#pragma unroll
        for (int j = 0; j < 4; ++j) { v[j] = xr[64 * j]; s += (v[j].x + v[j].y) + (v[j].z + v[j].w); }
        const float mean = wave_sum(s) * (1.f / DM); float s2 = 0.f;
#pragma unroll
        for (int j = 0; j < 4; ++j) { v[j] = v[j] - mean; s2 += (v[j].x * v[j].x + v[j].y * v[j].y) + (v[j].z * v[j].z + v[j].w * v[j].w); }
        const float rstd = 1.f / sqrtf(wave_sum(s2) * (1.f / DM) + LN_EPS);
        v2u* ob = (v2u*)(XB + (size_t)r * DM) + lane;
#pragma unroll
        for (int j = 0; j < 4; ++j) { const f32x4 o = v[j] * rstd * gv[j] + bv[j]; xr[64 * j] = o; v2u w; w.x = pk2(o.x, o.y); w.y = pk2(o.z, o.w); ob[64 * j] = w; }
    }
}

__device__ __forceinline__ void attn_simple(const bf16* QKVp, bf16* Og, float* lse, int lane, int gw, int NGW) {
    const int NT = CH_SEQ * 3 * 8 * SEQL;
    const int per = (NT + NGW - 1) / NGW;
    const int t0 = gw * per, t1 = (t0 + per < NT) ? (t0 + per) : NT;
    for (int task = t0; task < t1; ++task) {
        const int tok = task & (SEQL - 1); const int pl = task >> 11; const int h = pl & 7; const int g = (pl >> 3) % 3; const int sq = pl / 24;
        const int sh = 2 * g, dil = 1 << sh, L = SEQL >> sh, r = tok & (dil - 1), p = tok >> sh;
        const bf16* Qp = QKVp + ((size_t)(((sq * 3 + g) * 3 + 0) * 8 + h) * SEQL) * 128;
        const bf16* Kp = QKVp + ((size_t)(((sq * 3 + g) * 3 + 1) * 8 + h) * SEQL) * 128;
        const bf16* Vp = QKVp + ((size_t)(((sq * 3 + g) * 3 + 2) * 8 + h) * SEQL) * 128;
        const v4u* qrow = (const v4u*)(Qp + (size_t)tok * 128);
        float sv[3];
#pragma unroll
        for (int e = 0; e < 3; ++e) {
            const int jj = lane + 64 * e; const int pp = p - 64 + jj; const bool ok = (jj <= 128) && (pp >= 0) && (pp < L);
            float s = -1e30f;
            if (ok) { const v4u* krow = (const v4u*)(Kp + (size_t)(r + dil * pp) * 128); float acc = 0.f;
#pragma unroll
                for (int c = 0; c < 16; ++c) { const v4u qv = qrow[c], kv = krow[c]; acc = dot2bf(qv.x, kv.x, acc); acc = dot2bf(qv.y, kv.y, acc); acc = dot2bf(qv.z, kv.z, acc); acc = dot2bf(qv.w, kv.w, acc); }
                s = acc; }
            sv[e] = s;
        }
        const float mx = wave_max(fmaxf(fmaxf(sv[0], sv[1]), sv[2]));
        float pv[3];
#pragma unroll
        for (int e = 0; e < 3; ++e) pv[e] = (sv[e] > -1e29f) ? exp2f(sv[e] - mx) : 0.f;
        const float den = wave_sum(pv[0] + pv[1] + pv[2]);
        float o0 = 0.f, o1 = 0.f;
        for (int jj = 0; jj <= 128; ++jj) {
            const float pj = __shfl(jj < 64 ? pv[0] : (jj < 128 ? pv[1] : pv[2]), jj & 63);
            if (pj != 0.f) { const int pp = p - 64 + jj; const unsigned vw = *((const unsigned*)(Vp + (size_t)(r + dil * pp) * 128) + lane); o0 += pj * bflo(vw); o1 += pj * bfhi(vw); }
        }
        const float inv = 1.f / den; const int row = sq * SEQL + tok;
        *((unsigned*)(Og + ((size_t)g * CH_ROWS + row) * DM + h * 128) + lane) = pk2(o0 * inv, o1 * inv);
        if (lane == 0) lse[((size_t)g * CH_ROWS + row) * 8 + h] = mx + log2f(den);
    }
}
__device__ __forceinline__ void combine_rows(const bf16* Og, const float* lse, bf16* OC, int lane, int gw, int NGW) {
    for (int row = gw; row < CH_ROWS; row += NGW) {
        const int h = lane >> 3;
        float l0 = lse[((size_t)0 * CH_ROWS + row) * 8 + h], l1 = lse[((size_t)1 * CH_ROWS + row) * 8 + h], l2 = lse[((size_t)2 * CH_ROWS + row) * 8 + h];
        const float mx = fmaxf(fmaxf(l0, l1), l2); float w0 = exp2f(l0 - mx), w1 = exp2f(l1 - mx), w2 = exp2f(l2 - mx); const float inv = 1.f / (w0 + w1 + w2); w0 *= inv; w1 *= inv; w2 *= inv;
        const v4u* a0 = (const v4u*)(Og + ((size_t)0 * CH_ROWS + row) * DM) + 2 * lane; const v4u* a1 = (const v4u*)(Og + ((size_t)1 * CH_ROWS + row) * DM) + 2 * lane; const v4u* a2 = (const v4u*)(Og + ((size_t)2 * CH_ROWS + row) * DM) + 2 * lane;
        v4u* o = (v4u*)(OC + (size_t)row * DM) + 2 * lane;
#pragma unroll
        for (int q = 0; q < 2; ++q) { const v4u x0 = a0[q], x1 = a1[q], x2 = a2[q]; v4u w;
#define CMB(c) pk2(w0 * bflo(x0.c) + w1 * bflo(x1.c) + w2 * bflo(x2.c), w0 * bfhi(x0.c) + w1 * bfhi(x1.c) + w2 * bfhi(x2.c))
            w.x = CMB(x); w.y = CMB(y); w.z = CMB(z); w.w = CMB(w);
#undef CMB
            o[q] = w; }
    }
}
__device__ __forceinline__ void conv_rows(const bf16* H, const bf16* GB, const float* ck, bf16* Y, int lane, int gw, int NGW) {
    for (int row = gw; row < M_TOK; row += NGW) {
        const int t = row & (SEQL - 1);
#pragma unroll
        for (int q = 0; q < 2; ++q) {
            const int c0 = 512 * q + 8 * lane;
            const v4u hm = (t > 0) ? *(const v4u*)(H + (size_t)(row - 1) * DM + c0) : (v4u){0u, 0u, 0u, 0u};
            const v4u hc = *(const v4u*)(H + (size_t)row * DM + c0);
            const v4u hn = (t < SEQL - 1) ? *(const v4u*)(H + (size_t)(row + 1) * DM + c0) : (v4u){0u, 0u, 0u, 0u};
            const v4u gb = *(const v4u*)(GB + (size_t)row * DM + c0);
            float k0[8], k1[8], k2[8];
#pragma unroll
            for (int e = 0; e < 2; ++e) { const f32x4 a = *(const f32x4*)(ck + c0 + 4 * e), b = *(const f32x4*)(ck + DM + c0 + 4 * e), c = *(const f32x4*)(ck + 2 * DM + c0 + 4 * e);
                k0[4 * e] = a.x; k0[4 * e + 1] = a.y; k0[4 * e + 2] = a.z; k0[4 * e + 3] = a.w; k1[4 * e] = b.x; k1[4 * e + 1] = b.y; k1[4 * e + 2] = b.z; k1[4 * e + 3] = b.w; k2[4 * e] = c.x; k2[4 * e + 1] = c.y; k2[4 * e + 2] = c.z; k2[4 * e + 3] = c.w; }
            v4u w;
#define CV(c, e) pk2(bflo(gb.c) * (k0[e] * bflo(hm.c) + k1[e] * bflo(hc.c) + k2[e] * bflo(hn.c)), bfhi(gb.c) * (k0[e + 1] * bfhi(hm.c) + k1[e + 1] * bfhi(hc.c) + k2[e + 1] * bfhi(hn.c)))
            w.x = CV(x, 0); w.y = CV(y, 2); w.z = CV(z, 4); w.w = CV(w, 6);
#undef CV
            *(v4u*)(Y + (size_t)row * DM + c0) = w;
        }
    }
}
__device__ __forceinline__ void argmax_step(float& bv, int& bi) {
#pragma unroll
    for (int o = 1; o < 64; o <<= 1) { const float ov = __shfl_xor(bv, o); const int oi = __shfl_xor(bi, o); const bool take = (ov > bv) || (ov == bv && oi < bi); bv = take ? ov : bv; bi = take ? oi : bi; }
}
__device__ __forceinline__ void select_simple(const bf16* Qp, const bf16* SK, v2u* SEL, int lane, int gw, int NGW) {
    const int NT = M_TOK * 8;
    const int per = (NT + NGW - 1) / NGW;
    const int t0 = gw * per, t1 = (t0 + per < NT) ? (t0 + per) : NT;
    for (int task = t0; task < t1; ++task) {
        const int tok = task >> 3, h = task & 7;
        float topv[2]; int topi[2];
#pragma unroll
        for (int p = 0; p < 2; ++p) {
            const v4u* qrow = (const v4u*)(Qp + (size_t)tok * PQ_N + h * 256 + p * 128);
            const v4u* k0 = (const v4u*)(SK + ((size_t)(h * 2 + p) * 128 + lane) * 128);
            const v4u* k1 = (const v4u*)(SK + ((size_t)(h * 2 + p) * 128 + lane + 64) * 128);
            float s0 = 0.f, s1 = 0.f;
#pragma unroll
            for (int c = 0; c < 16; ++c) { const v4u qv = qrow[c], a = k0[c], b = k1[c];
                s0 = dot2bf(qv.x, a.x, s0); s0 = dot2bf(qv.y, a.y, s0); s0 = dot2bf(qv.z, a.z, s0); s0 = dot2bf(qv.w, a.w, s0);
                s1 = dot2bf(qv.x, b.x, s1); s1 = dot2bf(qv.y, b.y, s1); s1 = dot2bf(qv.z, b.z, s1); s1 = dot2bf(qv.w, b.w, s1); }
            float myv = -3e38f; int myi = 0;
            for (int k = 0; k < 16; ++k) {
                float bv = (s0 >= s1) ? s0 : s1; int bi = (s0 >= s1) ? lane : lane + 64;
                argmax_step(bv, bi);
                if (lane == k) { myv = bv; myi = bi; }
                if (bi == lane) s0 = -3e38f;
                if (bi == lane + 64) s1 = -3e38f;
            }
            topv[p] = myv; topi[p] = myi;
        }
        float cv[4];
        const float av = __shfl(topv[0], lane >> 2);
#pragma unroll
        for (int e = 0; e < 4; ++e) cv[e] = av + __shfl(topv[1], 4 * (lane & 3) + e);
        float fv = -3e38f; int fc = 0;
        for (int k = 0; k < 16; ++k) {
            float bv = cv[0]; int bi = 4 * lane;
#pragma unroll
            for (int e = 1; e < 4; ++e) if (cv[e] > bv) { bv = cv[e]; bi = 4 * lane + e; }
            argmax_step(bv, bi);
            if (lane == k) { fv = bv; fc = bi; }
#pragma unroll
            for (int e = 0; e < 4; ++e) if (bi == 4 * lane + e) cv[e] = -3e38f;
        }
        const int ea = __shfl(topi[0], (fc >> 4) & 15), eb = __shfl(topi[1], fc & 15);
        const float fmax_ = __shfl(fv, 0);
        const float ex = (lane < 16) ? __expf(fv - fmax_) : 0.f;
        const float sum = wave_sum(ex);
        if (lane < 16) { v2u o; o.x = (unsigned)(ea * 128 + eb); o.y = __builtin_bit_cast(unsigned, ex / sum); SEL[((size_t)tok * 8 + h) * 16 + lane] = o; }
    }
}
__device__ __forceinline__ float gelu_erf(float x) { return 0.5f * x * (1.0f + erff(x * 0.70710678118654752f)); }
__device__ __forceinline__ void gather_rows(float* X, bf16* XB, const v2u* SEL, const bf16* U, const bf16* V, const float* gain, const float* bias, int lane, int gw, int NGW) {
    for (int tok = gw; tok < M_TOK; tok += NGW) {
        const v2u sa = SEL[(size_t)tok * 128 + lane], sb = SEL[(size_t)tok * 128 + 64 + lane];
        const v4u x0 = *((const v4u*)(XB + (size_t)tok * DM) + lane), x1 = *((const v4u*)(XB + (size_t)tok * DM + 512) + lane);
        float f[16];
#pragma unroll
        for (int e = 0; e < 16; ++e) f[e] = 0.f;
        for (int b = 0; b < 32; ++b) {
            v4u u0[4], u1[4], w0[4], w1[4];
#pragma unroll
            for (int e = 0; e < 4; ++e) {
                const int k = 4 * b + e;
                const unsigned eid = (unsigned)__builtin_amdgcn_readlane((int)(k < 64 ? sa.x : sb.x), k & 63);
                const v4u* ur = (const v4u*)(U + (size_t)eid * DM); const v4u* vr = (const v4u*)(V + (size_t)eid * DM);
                u0[e] = ur[lane]; u1[e] = ur[64 + lane]; w0[e] = vr[lane]; w1[e] = vr[64 + lane];
            }
#pragma unroll
            for (int e = 0; e < 4; ++e) {
                const int k = 4 * b + e;
                float d = 0.f;
                d = dot2bf(u0[e].x, x0.x, d); d = dot2bf(u0[e].y, x0.y, d); d = dot2bf(u0[e].z, x0.z, d); d = dot2bf(u0[e].w, x0.w, d);
                d = dot2bf(u1[e].x, x1.x, d); d = dot2bf(u1[e].y, x1.y, d); d = dot2bf(u1[e].z, x1.z, d); d = dot2bf(u1[e].w, x1.w, d);
                d = wave_sum(d);
                const float gk = __builtin_bit_cast(float, (unsigned)__builtin_amdgcn_readlane((int)(k < 64 ? sa.y : sb.y), k & 63));
                const float c = gk * gelu_erf(d);
                f[0] += c * bflo(w0[e].x); f[1] += c * bfhi(w0[e].x); f[2] += c * bflo(w0[e].y); f[3] += c * bfhi(w0[e].y);
                f[4] += c * bflo(w0[e].z); f[5] += c * bfhi(w0[e].z); f[6] += c * bflo(w0[e].w); f[7] += c * bfhi(w0[e].w);
                f[8] += c * bflo(w1[e].x); f[9] += c * bfhi(w1[e].x); f[10] += c * bflo(w1[e].y); f[11] += c * bfhi(w1[e].y);
                f[12] += c * bflo(w1[e].z); f[13] += c * bfhi(w1[e].z); f[14] += c * bflo(w1[e].w); f[15] += c * bfhi(w1[e].w);
            }
        }
        float* xr = X + (size_t)tok * DM;
        float z[16];
#pragma unroll
        for (int q = 0; q < 4; ++q) { const f32x4 xv = *(const f32x4*)(xr + (q >> 1) * 512 + 8 * lane + 4 * (q & 1)); z[4 * q] = DN_ALPHA * xv.x + f[4 * q]; z[4 * q + 1] = DN_ALPHA * xv.y + f[4 * q + 1]; z[4 * q + 2] = DN_ALPHA * xv.z + f[4 * q + 2]; z[4 * q + 3] = DN_ALPHA * xv.w + f[4 * q + 3]; }
        float s = 0.f;
#pragma unroll
        for (int e = 0; e < 16; ++e) s += z[e];
        const float mean = wave_sum(s) * (1.f / DM); float s2 = 0.f;
#pragma unroll
        for (int e = 0; e < 16; ++e) { z[e] -= mean; s2 += z[e] * z[e]; }
        const float rstd = 1.f / sqrtf(wave_sum(s2) * (1.f / DM) + LN_EPS);
#pragma unroll
        for (int q = 0; q < 4; ++q) { const int c = (q >> 1) * 512 + 8 * lane + 4 * (q & 1); const f32x4 gv = *(const f32x4*)(gain + c), bv = *(const f32x4*)(bias + c);
            f32x4 o; o.x = z[4 * q] * rstd * gv.x + bv.x; o.y = z[4 * q + 1] * rstd * gv.y + bv.y; o.z = z[4 * q + 2] * rstd * gv.z + bv.z; o.w = z[4 * q + 3] * rstd * gv.w + bv.w;
            *(f32x4*)(xr + c) = o; v2u w; w.x = pk2(o.x, o.y); w.y = pk2(o.z, o.w); *(v2u*)(XB + (size_t)tok * DM + c) = w; }
    }
}

__global__ void __launch_bounds__(NTHR, 2) mk_fwd(Args args) {
    extern __shared__ __attribute__((aligned(16))) unsigned char lds_raw[];
    LAS unsigned char* lds = (LAS unsigned char*)lds_raw;
    const int tid = threadIdx.x, lane0_ = tid & 63, wave = __builtin_amdgcn_readfirstlane(tid >> 6);
    const int G = gridDim.x, bid = blockIdx.x;
    const int gw = bid * NWAVES + wave, NGW = G * NWAVES;
    unsigned char* ws0_ = args.ws; float* X0_ = args.out;
    const int lo = args.ph_lo, hi = args.ph_hi;
    volatile LAS unsigned* MISC = (volatile LAS unsigned*)(lds + MISC_OFF);
    if (tid < 128) MISC[tid] = 0u;
    __syncthreads();
    XcdBarrier bar; bar.bar = (unsigned*)(ws0_ + WS_CTL) + CW_BAR; bar.x = 0; bar.st = MISC;
    if (hi - lo > 1) bar = xcd_barrier_post((unsigned*)(ws0_ + WS_CTL) + CW_BAR, MISC);
    int ph = 0;
#define PH_BEGIN if (ph >= lo && ph < hi) { int lane = lane0_; asm volatile("" : "+v"(lane)); unsigned char* ws = ws0_; asm volatile("" : "+s"(ws)); float* X = X0_; asm volatile("" : "+s"(X)); \
        bf16* A1 = (bf16*)(ws + WS_A1); bf16* A2 = (bf16*)(ws + WS_A2); (void)A1; (void)A2; (void)X; (void)lane;
#define PH_END   if (ph + 1 < hi) xcd_barrier(bar); } ++ph;
#define QKVp ((bf16*)(ws + WS_R1))
#define Og ((bf16*)(ws + WS_R2 + R2_OG))
#define lse ((float*)(ws + WS_R2 + R2_LSE))
#define Hc ((bf16*)(ws + WS_R1 + R1_H))
#define GBc ((bf16*)(ws + WS_R1 + R1_GB))
#define Qp ((bf16*)(ws + WS_R1 + R1_QP))
#define PP ((bf16*)(ws + WS_R1 + R1_PP))
#define SEL ((v2u*)(ws + WS_R2 + R2_SEL))

    PH_BEGIN prologue(args, ws, lds, tid, lane, wave, bid, G); PH_END

    for (int i = 0; i < 4; ++i) {
        const int j = i >> 1;
        if ((i & 1) == 0) {
            for (int c = 0; c < NCHUNK; ++c) {
                PH_BEGIN {
                    pg8::Gemm g{A2 + (size_t)c * CH_ROWS * DM, (const bf16*)(ws + WS_WQKV) + (size_t)j * QKV_N * 1024, CH_ROWS, QKV_N, 1024};
                    pg8::StaticOrder S; S.init(CH_ROWS, QKV_N, G, bid);
                    EpiQKV E{QKVp, (const f32x2*)(ws + WS_ROPE)};
                    pg8::gemm_phase<EpiQKV, pg8::StaticOrder, false>(lds, g, S, E, nullptr);
                } PH_END
                PH_BEGIN attn_simple(QKVp, Og, lse, lane, gw, NGW); PH_END
                PH_BEGIN combine_rows(Og, lse, A2 + (size_t)c * CH_ROWS * DM, lane, gw, NGW); PH_END
            }
        } else {
            PH_BEGIN {
                pg8::Gemm g{A2, (const bf16*)(ws + WS_WCIN) + (size_t)j * 3072 * 1024, M_TOK, 3072, 1024};
                pg8::StaticOrder S; S.init(M_TOK, 3072, G, bid);
                EpiCin E{Hc, GBc};
                pg8::gemm_phase<EpiCin, pg8::StaticOrder, false>(lds, g, S, E, nullptr);
            } PH_END
            PH_BEGIN conv_rows(Hc, GBc, args.in[7] + (size_t)j * 3 * DM, A2, lane, gw, NGW); PH_END
        }
        PH_BEGIN {
            const bf16* Wt = (i & 1) ? (const bf16*)(ws + WS_WCOUT) + (size_t)j * 1024 * 1024 : (const bf16*)(ws + WS_WO) + (size_t)j * 1024 * 1024;
            pg8::Gemm g{A2, Wt, M_TOK, DM, 1024};
            pg8::StaticOrder S; S.init(M_TOK, DM, G, bid);
            EpiResid E{X};
            pg8::gemm_phase<EpiResid, pg8::StaticOrder, false>(lds, g, S, E, nullptr);
        } PH_END
        PH_BEGIN ln_rows(X, A1, args.in[13] + (size_t)i * DM, args.in[14] + (size_t)i * DM, lane, gw, NGW); PH_END
        PH_BEGIN {
            {
                pg8::Gemm g{A1, (const bf16*)(ws + WS_WPQ) + (size_t)i * PQ_N * 1024, M_TOK, PQ_N, 1024};
                pg8::StaticOrder S; S.init(M_TOK, PQ_N, G, bid);
                pg8::EpiBf16<0> E{Qp, PQ_N, nullptr, 0, 0};
                pg8::gemm_phase<pg8::EpiBf16<0>, pg8::StaticOrder, false>(lds, g, S, E, nullptr);
            }
            __syncthreads();
            {
                pg8::Gemm g{(const bf16*)(ws + WS_PB) + (size_t)i * M_TOK * PLE_K, (const bf16*)(ws + WS_WPP) + (size_t)i * 1024 * PLE_K, M_TOK, DM, PLE_K};
                pg8::StaticOrder S; S.init(M_TOK, DM, G, bid);
                pg8::EpiBf16<0> E{PP, DM, nullptr, 0, 0};
                pg8::gemm_phase<pg8::EpiBf16<0>, pg8::StaticOrder, false>(lds, g, S, E, nullptr);
            }
        } PH_END
        PH_BEGIN select_simple(Qp, (const bf16*)(ws + WS_SK) + (size_t)i * 8 * 2 * 128 * 128, SEL, lane, gw, NGW); PH_END
        PH_BEGIN gather_rows(X, A1, SEL, (const bf16*)(ws + WS_U) + (size_t)i * NEXP * DM, (const bf16*)(ws + WS_V) + (size_t)i * NEXP * DM,
                             args.in[15] + (size_t)i * DM, args.in[16] + (size_t)i * DM, lane, gw, NGW); PH_END
        PH_BEGIN {
            pg8::Gemm g{A1, (const bf16*)(ws + WS_WG) + (size_t)i * 1024 * 1024, M_TOK, DM, 1024};
            pg8::StaticOrder S; S.init(M_TOK, DM, G, bid);
            EpiGate E{X, PP, A2};
            pg8::gemm_phase<EpiGate, pg8::StaticOrder, false>(lds, g, S, E, nullptr);
        } PH_END
    }
#undef PH_BEGIN
#undef PH_END
#undef QKVp
#undef Og
#undef lse
#undef Hc
#undef GBc
#undef Qp
#undef PP
#undef SEL
}

extern "C" void kernel_launch(void* const* d_in, const int* in_sizes, int n_in, void* d_out, int out_size, void* d_ws, size_t ws_size, hipStream_t stream) {
    static int grid = 0;
    if (grid == 0) {
        if (n_in != 19 || out_size != M_TOK * DM || ws_size < WS_END) { fprintf(stderr, "kernel_launch: unexpected shapes (n_in %d out %d ws %zu)\n", n_in, out_size, ws_size); grid = -1; return; }
        int dev = 0, cus = 0, per_cu = 0;
        if (hipGetDevice(&dev) != hipSuccess || hipDeviceGetAttribute(&cus, hipDeviceAttributeMultiprocessorCount, dev) != hipSuccess) { grid = -1; return; }
        if (hipFuncSetAttribute((const void*)mk_fwd, hipFuncAttributeMaxDynamicSharedMemorySize, LDS_BYTES) != hipSuccess) { fprintf(stderr, "kernel_launch: hipFuncSetAttribute failed\n"); grid = -1; return; }
        if (hipOccupancyMaxActiveBlocksPerMultiprocessor(&per_cu, (const void*)mk_fwd, NTHR, LDS_BYTES) != hipSuccess || per_cu < 1) { fprintf(stderr, "kernel_launch: occupancy query says %d\n", per_cu); }
        (void)hipGetLastError();
        grid = cus;
    }
    if (grid < 0) return;
    (void)hipMemsetAsync((char*)d_ws + WS_CTL, 0, CTL_ZERO_BYTES, stream);
    Args a{};
    for (int i = 0; i < 19; ++i) a.in[i] = (const float*)d_in[i];
    a.out = (float*)d_out; a.ws = (unsigned char*)d_ws;
    static const float invf[16] = {1.0f, 0.44036659598350525f, 0.1939227432012558f, 0.08539710193872452f, 0.03760603070259094f, 0.01656043902039528f, 0.007292664609849453f, 0.0032114458736032248f,
                                   0.0014142135623842478f, 0.000622772378847003f, 0.00027424818836152554f, 0.00012076973507646471f, 5.318296098266728e-05f, 2.34199997066753e-05f, 1.0313386155758053e-05f, 4.541670477919979e-06f};
    for (int i = 0; i < 16; ++i) a.inv_freq[i] = invf[i];
#if ONE_LAUNCH
    a.ph_lo = 0; a.ph_hi = N_PHASES;
    hipLaunchKernelGGL(mk_fwd, dim3(grid), dim3(NTHR), LDS_BYTES, stream, a);
#else
    for (int p = 0; p < N_PHASES; ++p) { a.ph_lo = p; a.ph_hi = p + 1; hipLaunchKernelGGL(mk_fwd, dim3(grid), dim3(NTHR), LDS_BYTES, stream, a); }
#endif
}
```

```cpp
#include <hip/hip_runtime.h>
#include <stdint.h>
#include <stdio.h>
namespace pg8 {
#define PG8_LAS __attribute__((address_space(3)))
typedef unsigned short bf16_t;
typedef short bf16x8 __attribute__((ext_vector_type(8)));
typedef float f32x4 __attribute__((ext_vector_type(4)));
typedef unsigned u32x4 __attribute__((ext_vector_type(4)));
typedef int i32x4 __attribute__((ext_vector_type(4)));
constexpr int BM = 256, BK = 64, HALF = 128, HTB = HALF * BK * 2  , STAGE_BYTES = 8 * HTB, NXCD = 8, WGM = 8;

__host__ __device__ __forceinline__ int lds_byte(int r, int c) { const int st = (r >> 4) * 2 + (c >> 5), rr = r & 15, cc = c & 31, ob = rr * 64 + cc * 2; return st * 1024 + (ob ^ (((ob >> 9) & 1) << 5)); }
__host__ __device__ __forceinline__ void stage_rc(int b, int& R, int& C) { const int st = b / 1024, sb = b % 1024, swz = sb ^ (((sb >> 9) & 1) << 5); R = (st >> 1) * 16 + swz / 64; C = (st & 1) * 32 + (swz % 64) / 2; }
__host__ __device__ __forceinline__ int perm32(int rho) { const int n = rho >> 4, i = rho & 15; return 8 * (i >> 2) + 4 * n + (i & 3); }

struct Unit { int pm, pn; };
struct Gemm { const bf16_t* A; const bf16_t* Bt; int M, N, K; };

struct StaticOrder {
    int nM, nN, nwg, G, c;
    __host__ __device__ void init(int M, int N, int G_, int c_) { nM = M / BM; nN = N / BM; nwg = nM * nN; G = G_; c = c_; }
    __host__ __device__ bool next(int i, Unit& u) const {
        const long L = (long)i * G + c; if (L >= nwg) return false;
        int wgid = (int)L; { const int q = nwg / NXCD, r = nwg % NXCD, xcd = wgid % NXCD, off = wgid / NXCD; wgid = (xcd < r ? xcd * (q + 1) : r * (q + 1) + (xcd - r) * q) + off; }
        const int nig = WGM * nN, gid = wgid / nig, fm = gid * WGM, gsz = (nM - fm) < WGM ? (nM - fm) : WGM;
        u.pm = fm + ((wgid % nig) % gsz); u.pn = (wgid % nig) / gsz; return true;
    }
    __device__ __forceinline__ void a_ready(const Unit&) const {}
    __device__ __forceinline__ void done(const Unit&) const {}
};
struct CountedOrder : StaticOrder {
    const unsigned* ready; unsigned need; unsigned* tmo;
    __device__ __forceinline__ void a_ready(const Unit& u) const {
        if (threadIdx.x < 64) {
            const unsigned long long t0 = __builtin_amdgcn_s_memrealtime(); unsigned polls = 0;
            while ((unsigned)__builtin_amdgcn_readfirstlane(__hip_atomic_load(ready + 64 * u.pm, __ATOMIC_RELAXED, __HIP_MEMORY_SCOPE_AGENT)) < need) {
                if ((++polls & 255u) == 0u && __builtin_amdgcn_readfirstlane(__hip_atomic_load(tmo, __ATOMIC_RELAXED, __HIP_MEMORY_SCOPE_AGENT)) != 0u) break;
                if (__builtin_amdgcn_s_memrealtime() - t0 > 2000000ull) {
                    if (threadIdx.x == 0) { unsigned expect = 0u; __hip_atomic_compare_exchange_strong(tmo + 1, &expect, 0x600u | (unsigned)(u.pm & 0xff), __ATOMIC_RELAXED, __ATOMIC_RELAXED, __HIP_MEMORY_SCOPE_AGENT); __hip_atomic_store(tmo, 1u, __ATOMIC_RELAXED, __HIP_MEMORY_SCOPE_AGENT); }
                    break; }
                __builtin_amdgcn_s_sleep(2); }
            __builtin_amdgcn_fence(__ATOMIC_ACQUIRE, "agent");
            asm volatile("s_waitcnt vmcnt(0)" ::: "memory");
        }
#if !defined(BROKEN_HOOK_NO_BARRIER)
        asm volatile("" ::: "memory"); __builtin_amdgcn_s_barrier(); asm volatile("" ::: "memory");
#endif
    }
};

__device__ __forceinline__ unsigned cvt_pk_bf16(float lo, float hi) { unsigned r; asm volatile("v_cvt_pk_bf16_f32 %0, %1, %2" : "=v"(r) : "v"(lo), "v"(hi)); return r; }
typedef float f32x2 __attribute__((ext_vector_type(2)));
__device__ __forceinline__ f32x2 gelu_pk(f32x2 v) {
    const f32x2 av = __builtin_elementwise_abs(v), d = av * 0.2316418882f + 1.0f;
    f32x2 t; t.x = __builtin_amdgcn_rcpf(d.x); t.y = __builtin_amdgcn_rcpf(d.y);
    f32x2 q = t * 0.5307027145f + (-0.7265760135f); q = q * t + 0.7107068705f; q = q * t + (-0.142248368f); q = q * t + 0.127414796f; q = q * t;
    const f32x2 s = (v * v) * (-0.72134752044f);
    f32x2 e; e.x = __builtin_amdgcn_exp2f(s.x); e.y = __builtin_amdgcn_exp2f(s.y);
    const f32x2 m = v * (q * e), r = v - m;
    f32x2 o; o.x = v.x < 0.f ? m.x : r.x; o.y = v.y < 0.f ? m.y : r.y; return o;
}

struct EpiF32 {
    static constexpr bool PERM = false, AFTER_DRAIN = false;
    float* C; int ldc; const float* bias;
    __device__ __forceinline__ void operator()(const f32x4 (&acc)[2][2][4][2], const Unit& u, int wr, int wc, int fr, int fq) const {
        const int row0 = u.pm * BM + wr * 64 + fr, col0 = u.pn * BM + wc * 32 + 4 * fq;
        f32x4 bv[2][2];
#pragma unroll
        for (int bj = 0; bj < 2; ++bj)
#pragma unroll
            for (int n = 0; n < 2; ++n) bv[bj][n] = bias ? *(const f32x4*)(bias + col0 + bj * HALF + n * 16) : (f32x4){0.f, 0.f, 0.f, 0.f};
#pragma unroll
        for (int ai = 0; ai < 2; ++ai)
#pragma unroll
            for (int m = 0; m < 4; ++m) { float* rowp = C + (size_t)(row0 + ai * HALF + m * 16) * ldc + col0;
#pragma unroll
                for (int bj = 0; bj < 2; ++bj)
#pragma unroll
                    for (int n = 0; n < 2; ++n) *(f32x4*)(rowp + bj * HALF + n * 16) = acc[ai][bj][m][n] + bv[bj][n]; }
    }
};
template <int ACT  > struct EpiBf16 {
    static constexpr bool PERM = true, AFTER_DRAIN = false;
    bf16_t* O; int ldc; const float* bias; int split_cols; size_t split_stride;
    __device__ __forceinline__ void operator()(const f32x4 (&acc)[2][2][4][2], const Unit& u, int wr, int wc, int fr, int fq) const {
        const int row0 = u.pm * BM + wr * 64 + fr; int colt = u.pn * BM; bf16_t* base = O;
        if (split_cols) { const int t = colt / split_cols; base += (size_t)t * split_stride; colt -= t * split_cols; }
        const int col0 = colt + wc * 32 + 8 * fq, bcol0 = u.pn * BM + wc * 32 + 8 * fq;
        f32x4 bv[2][2];
#pragma unroll
        for (int bj = 0; bj < 2; ++bj)
#pragma unroll
            for (int n = 0; n < 2; ++n) bv[bj][n] = bias ? *(const f32x4*)(bias + bcol0 + bj * HALF + 4 * n) : (f32x4){0.f, 0.f, 0.f, 0.f};
#pragma unroll
        for (int ai = 0; ai < 2; ++ai)
#pragma unroll
            for (int m = 0; m < 4; ++m) { bf16_t* rowp = base + (size_t)(row0 + ai * HALF + m * 16) * ldc + col0;
#pragma unroll
                for (int bj = 0; bj < 2; ++bj) { f32x4 v0 = acc[ai][bj][m][0] + bv[bj][0], v1 = acc[ai][bj][m][1] + bv[bj][1];
                    if (ACT == 1) { f32x2 a = gelu_pk((f32x2){v0[0], v0[1]}), b = gelu_pk((f32x2){v0[2], v0[3]}), c = gelu_pk((f32x2){v1[0], v1[1]}), d = gelu_pk((f32x2){v1[2], v1[3]});
                        v0 = (f32x4){a.x, a.y, b.x, b.y}; v1 = (f32x4){c.x, c.y, d.x, d.y}; }
                    if (ACT == 2) {
#pragma unroll
                        for (int j = 0; j < 4; ++j) { v0[j] = 0.5f * v0[j] * (1.0f + erff(v0[j] * 0.70710678f)); v1[j] = 0.5f * v1[j] * (1.0f + erff(v1[j] * 0.70710678f)); } }
                    u32x4 w; w.x = cvt_pk_bf16(v0[0], v0[1]); w.y = cvt_pk_bf16(v0[2], v0[3]); w.z = cvt_pk_bf16(v1[0], v1[1]); w.w = cvt_pk_bf16(v1[2], v1[3]);
                    *(u32x4*)(rowp + bj * HALF) = w; } }
    }
};

struct PanelStats {
    unsigned* xbuf;
    unsigned* cnt;
    unsigned* tmo;
    int ntn; float eps;
    unsigned code;
    __device__ __forceinline__ bool run(const f32x4 (&v)[2][2][4][2], const Unit& u, int wr, int wc, int fr, int fq, PG8_LAS unsigned char* lds, int wid, int lane) const {
        typedef float f32x2v __attribute__((ext_vector_type(2)));
        PG8_LAS f32x2v* P = (PG8_LAS f32x2v*)lds;
        PG8_LAS f32x2v* S = (PG8_LAS f32x2v*)(lds + 8192);
        PG8_LAS unsigned* flag = (PG8_LAS unsigned*)(lds + 8192 + 2048);
#pragma unroll
        for (int ai = 0; ai < 2; ++ai)
#pragma unroll
            for (int m = 0; m < 4; ++m) {
                float s = 0.f;
#pragma unroll
                for (int bj = 0; bj < 2; ++bj)
#pragma unroll
                    for (int n = 0; n < 2; ++n) { const f32x4 x = v[ai][bj][m][n]; s += (x[0] + x[1]) + (x[2] + x[3]); }
                s += __shfl_xor(s, 16); s += __shfl_xor(s, 32);
                const float mw = s * (1.0f / 64.0f); float q = 0.f;
#pragma unroll
                for (int bj = 0; bj < 2; ++bj)
#pragma unroll
                    for (int n = 0; n < 2; ++n) { const f32x4 d = v[ai][bj][m][n] - mw; q += (d[0] * d[0] + d[1] * d[1]) + (d[2] * d[2] + d[3] * d[3]); }
                q += __shfl_xor(q, 16); q += __shfl_xor(q, 32);
                if (fq == 0) P[(ai * HALF + wr * 64 + m * 16 + fr) * 4 + wc] = (f32x2v){mw, q};
            }
        asm volatile("s_waitcnt lgkmcnt(0)" ::: "memory"); __builtin_amdgcn_s_barrier(); asm volatile("" ::: "memory");
#if defined(BROKEN_NO_WAIT)
        if (blockIdx.x >= 64) { const long long t0 = clock64(); while (clock64() - t0 < 60000) __builtin_amdgcn_s_sleep(8); }
#endif
        const int row = wid * 32 + (lane & 31);
        if (lane < 32) {
            const f32x2v a = P[row * 4 + 0], b = P[row * 4 + 1], c = P[row * 4 + 2], d = P[row * 4 + 3];
            const float mt = (a.x + b.x + c.x + d.x) * 0.25f;
            const float da = a.x - mt, db = b.x - mt, dc = c.x - mt, dd = d.x - mt;
            const float m2 = (a.y + b.y) + (c.y + d.y) + 64.0f * ((da * da + db * db) + (dc * dc + dd * dd));
            unsigned long long* slot = (unsigned long long*)xbuf + ((size_t)(u.pm * BM + row) * 4 + u.pn);
            __hip_atomic_store(slot, ((unsigned long long)__float_as_uint(m2) << 32) | __float_as_uint(mt), __ATOMIC_RELAXED, __HIP_MEMORY_SCOPE_AGENT);
        }
        asm volatile("s_waitcnt vmcnt(0)" ::: "memory");
        if (lane == 0) __hip_atomic_fetch_add(cnt + 64 * u.pm, 1u, __ATOMIC_RELAXED, __HIP_MEMORY_SCOPE_AGENT);
        if (wid == 0) {
            bool dead = false; const unsigned long long t0 = __builtin_amdgcn_s_memrealtime(); const unsigned want = 8u * (unsigned)ntn;
            for (;;) {
#if defined(BROKEN_NO_WAIT)
                break;
#endif
                if ((unsigned)__builtin_amdgcn_readfirstlane(__hip_atomic_load(cnt + 64 * u.pm, __ATOMIC_RELAXED, __HIP_MEMORY_SCOPE_AGENT)) >= want) break;
                if (__builtin_amdgcn_s_memrealtime() - t0 > 2000000ull) {
                    if (lane == 0) { unsigned expect = 0u; __hip_atomic_compare_exchange_strong(tmo + 1, &expect, code | (unsigned)(u.pm & 0xff), __ATOMIC_RELAXED, __ATOMIC_RELAXED, __HIP_MEMORY_SCOPE_AGENT);
                                     __hip_atomic_store(tmo, 1u, __ATOMIC_RELAXED, __HIP_MEMORY_SCOPE_AGENT); }
                    dead = true; break; }
                __builtin_amdgcn_s_sleep(2);
            }
            __builtin_amdgcn_fence(__ATOMIC_ACQUIRE, "agent");
            if (lane == 0) flag[0] = dead ? 1u : 0u;
        }
        asm volatile("s_waitcnt vmcnt(0) lgkmcnt(0)" ::: "memory"); __builtin_amdgcn_s_barrier(); asm volatile("" ::: "memory");
        const bool bad = flag[0] != 0u;
        if (lane < 32) {
            const unsigned long long* slot = (const unsigned long long*)xbuf + (size_t)(u.pm * BM + row) * 4; float mt[4], m2[4]; float ms = 0.f;
#pragma unroll
            for (int t = 0; t < 4; ++t) { if (t < ntn) { const unsigned long long w = __hip_atomic_load(slot + t, __ATOMIC_RELAXED, __HIP_MEMORY_SCOPE_AGENT); mt[t] = __uint_as_float((unsigned)w); m2[t] = __uint_as_float((unsigned)(w >> 32)); } else { mt[t] = 0.f; m2[t] = 0.f; } ms += mt[t]; }
            const float mean = ms / (float)ntn; float q = 0.f;
#pragma unroll
            for (int t = 0; t < 4; ++t) if (t < ntn) { const float dm = mt[t] - mean; q += m2[t] + 256.0f * dm * dm; }
            S[row] = (f32x2v){mean, 1.0f / sqrtf(q / (256.0f * (float)ntn) + eps)};
        }
        asm volatile("s_waitcnt lgkmcnt(0)" ::: "memory"); __builtin_amdgcn_s_barrier(); asm volatile("" ::: "memory");
        return bad;
    }
};
struct EpiLnRes {
    static constexpr bool PERM = false, AFTER_DRAIN = true;
    const float* base; float* out; int ldc; const float* bias; PanelStats st; unsigned poison;
    __device__ __forceinline__ void refuse(size_t i0, size_t stride, int M, int N) const { const float q = __builtin_nanf(""); for (size_t i = i0; i < (size_t)M * N; i += stride) out[(i / N) * ldc + i % N] = q;
        if (i0 == 0) { unsigned expect = 0u; __hip_atomic_compare_exchange_strong(st.tmo + 1, &expect, 0x7f0u, __ATOMIC_RELAXED, __ATOMIC_RELAXED, __HIP_MEMORY_SCOPE_AGENT); __hip_atomic_store(st.tmo, 1u, __ATOMIC_RELAXED, __HIP_MEMORY_SCOPE_AGENT); } }
    __device__ __forceinline__ void fused(f32x4 (&acc)[2][2][4][2], const Unit& u, int wr, int wc, int fr, int fq, PG8_LAS unsigned char* lds, int wid, int lane) const {
        typedef float f32x2v __attribute__((ext_vector_type(2)));
        const PG8_LAS f32x2v* S = (const PG8_LAS f32x2v*)(lds + 8192);
        const int col0 = u.pn * BM + wc * 32 + 4 * fq;
#pragma unroll
        for (int bj = 0; bj < 2; ++bj)
#pragma unroll
            for (int n = 0; n < 2; ++n) { const f32x4 bv = bias ? *(const f32x4*)(bias + col0 + bj * HALF + n * 16) : (f32x4){0.f, 0.f, 0.f, 0.f};
#pragma unroll
                for (int ai = 0; ai < 2; ++ai)
#pragma unroll
                    for (int m = 0; m < 4; ++m) acc[ai][bj][m][n] += bv; }
        const bool bad = st.run(acc, u, wr, wc, fr, fq, lds, wid, lane) || poison != 0u;
        const float qnan = __builtin_nanf("");
#pragma unroll
        for (int ai = 0; ai < 2; ++ai)
#pragma unroll
            for (int m = 0; m < 4; ++m) { const int r = ai * HALF + wr * 64 + m * 16 + fr; const f32x2v sr = S[r]; const size_t off = (size_t)(u.pm * BM + r) * ldc + col0;
#pragma unroll
                for (int bj = 0; bj < 2; ++bj)
#pragma unroll
                    for (int n = 0; n < 2; ++n) { const f32x4 bs = *(const f32x4*)(base + off + bj * HALF + n * 16); f32x4 o = bs + (acc[ai][bj][m][n] - sr.x) * sr.y;
                        if (bad) o = (f32x4){qnan, qnan, qnan, qnan}; *(f32x4*)(out + off + bj * HALF + n * 16) = o; }
                asm volatile("" ::: "memory"); }
    }
};
struct EpiLnResLn {
    static constexpr bool PERM = false, AFTER_DRAIN = true;
    const float* base; float* out; bf16_t* xn; int ldc; const float* bias; PanelStats st1, st2; unsigned poison;
    __device__ __forceinline__ void refuse(size_t i0, size_t stride, int M, int N) const { const float q = __builtin_nanf(""); for (size_t i = i0; i < (size_t)M * N; i += stride) { const size_t o = (i / N) * ldc + i % N; out[o] = q; xn[o] = (bf16_t)0x7fc0u; }
        if (i0 == 0) { unsigned expect = 0u; __hip_atomic_compare_exchange_strong(st1.tmo + 1, &expect, 0x7f0u, __ATOMIC_RELAXED, __ATOMIC_RELAXED, __HIP_MEMORY_SCOPE_AGENT); __hip_atomic_store(st1.tmo, 1u, __ATOMIC_RELAXED, __HIP_MEMORY_SCOPE_AGENT); } }
    __device__ __forceinline__ void fused(f32x4 (&acc)[2][2][4][2], const Unit& u, int wr, int wc, int fr, int fq, PG8_LAS unsigned char* lds, int wid, int lane) const {
        typedef float f32x2v __attribute__((ext_vector_type(2))); typedef unsigned u32x2v __attribute__((ext_vector_type(2)));
        const PG8_LAS f32x2v* S = (const PG8_LAS f32x2v*)(lds + 8192);
        const int col0 = u.pn * BM + wc * 32 + 4 * fq;
#pragma unroll
        for (int bj = 0; bj < 2; ++bj)
#pragma unroll
            for (int n = 0; n < 2; ++n) { const f32x4 bv = bias ? *(const f32x4*)(bias + col0 + bj * HALF + n * 16) : (f32x4){0.f, 0.f, 0.f, 0.f};
#pragma unroll
                for (int ai = 0; ai < 2; ++ai)
#pragma unroll
                    for (int m = 0; m < 4; ++m) acc[ai][bj][m][n] += bv; }
        bool bad = st1.run(acc, u, wr, wc, fr, fq, lds, wid, lane) || poison != 0u;
        const float qnan = __builtin_nanf("");
#pragma unroll
        for (int ai = 0; ai < 2; ++ai)
#pragma unroll
            for (int m = 0; m < 4; ++m) { const int r = ai * HALF + wr * 64 + m * 16 + fr; const f32x2v sr = S[r]; const size_t off = (size_t)(u.pm * BM + r) * ldc + col0;
#pragma unroll
                for (int bj = 0; bj < 2; ++bj)
#pragma unroll
                    for (int n = 0; n < 2; ++n) { const f32x4 bs = *(const f32x4*)(base + off + bj * HALF + n * 16); acc[ai][bj][m][n] = bs + (acc[ai][bj][m][n] - sr.x) * sr.y; }
                asm volatile("" : "+v"(acc[ai][0][m][0]), "+v"(acc[ai][0][m][1]), "+v"(acc[ai][1][m][0]), "+v"(acc[ai][1][m][1]));
                if (m & 1) asm volatile("" ::: "memory"); }
        const bool bad1 = bad;
        bad = st2.run(acc, u, wr, wc, fr, fq, lds, wid, lane) || bad;
#pragma unroll
        for (int ai = 0; ai < 2; ++ai)
#pragma unroll
            for (int m = 0; m < 4; ++m) { const int r = ai * HALF + wr * 64 + m * 16 + fr; const f32x2v sr = S[r]; const size_t off = (size_t)(u.pm * BM + r) * ldc + col0;
#pragma unroll
                for (int bj = 0; bj < 2; ++bj)
#pragma unroll
                    for (int n = 0; n < 2; ++n) { const f32x4 x1 = acc[ai][bj][m][n]; *(f32x4*)(out + off + bj * HALF + n * 16) = bad1 ? (f32x4){qnan, qnan, qnan, qnan} : x1;
                        const f32x4 o = (x1 - sr.x) * sr.y; u32x2v w; w.x = cvt_pk_bf16(o[0], o[1]); w.y = cvt_pk_bf16(o[2], o[3]);
                        if (bad) { w.x = 0x7fc07fc0u; w.y = 0x7fc07fc0u; } *(u32x2v*)(xn + off + bj * HALF + n * 16) = w; }
                asm volatile("" ::: "memory"); }
    }
};

template <class Epi, class Sched, bool STAMP = false, bool I8 = false>
__device__ __forceinline__ void gemm_phase(PG8_LAS unsigned char* lds, const Gemm g, const Sched& S, const Epi& E, unsigned long long* stamps) {
    int tid_raw_ = threadIdx.x; asm volatile("" : "+v"(tid_raw_));
    const int tid = tid_raw_, wid = __builtin_amdgcn_readfirstlane(tid >> 6), lane = tid & 63, wr = wid >> 2, wc = wid & 3, fr = lane & 15, fq = lane >> 4;
    const int K = g.K, nt = K / BK;
    int ts_lo = 0, ts_hi = 0, nts = 0; const unsigned long long rt_entry = STAMP ? (unsigned long long)wall_clock64() : 0ull;
#define PG8_STAMP() do { if (STAMP && wid == 0 && nts < 64) { const unsigned long long _c = (unsigned long long)clock64(); \
        ts_lo = (lane == nts) ? (int)(unsigned)_c : ts_lo; ts_hi = (lane == nts) ? (int)(unsigned)(_c >> 32) : ts_hi; ++nts; } } while (0)
    PG8_STAMP();
    unsigned voffA[2], voffB[2];
#pragma unroll
    for (int i = 0; i < 2; ++i) { int R, C; stage_rc(tid * 16 + i * 8192, R, C); const int Rb = Epi::PERM ? ((R & ~31) + perm32(R & 31)) : R;
        voffA[i] = (unsigned)(R * K + C) * 2u; voffB[i] = (unsigned)(Rb * K + C) * 2u; }
    const size_t kstep = (size_t)(BK * 2);
    const size_t hstep = (size_t)HALF * K * 2;
    const size_t tstep = 2 * hstep;
    const unsigned ldsw = (unsigned)wid * 1024u;
    const int aoff = lds_byte(wr * 64 + fr, fq * 8), boff = lds_byte(wc * 32 + fr, fq * 8);
#define PG8_SA(b, h) (((b) * 2 + (h)) * HTB)
#define PG8_SB(b, h) ((4 + (b) * 2 + (h)) * HTB)
#define PG8_STAGE(bufoff, gbase, voff) do { _Pragma("unroll") for (int _i = 0; _i < 2; ++_i) \
        __builtin_amdgcn_global_load_lds((const unsigned*)((const char*)(gbase) + (voff)[_i]), (PG8_LAS unsigned*)(lds + (bufoff) + ldsw + _i * 8192), 16, 0, 0); } while (0)
#define PG8_LDA(dst, b, h) do { _Pragma("unroll") for (int m = 0; m < 4; ++m) _Pragma("unroll") for (int k = 0; k < 2; ++k) dst[m][k] = *(const PG8_LAS bf16x8*)(lds + PG8_SA(b, h) + aoff + m * 2048 + k * 1024); } while (0)
#define PG8_LDB(dst, b, h) do { _Pragma("unroll") for (int n = 0; n < 2; ++n) _Pragma("unroll") for (int k = 0; k < 2; ++k) dst[n][k] = *(const PG8_LAS bf16x8*)(lds + PG8_SB(b, h) + boff + n * 2048 + k * 1024); } while (0)
#define PG8_MMA(ai, bj, At, Bt) do { __builtin_amdgcn_s_setprio(1); _Pragma("unroll") for (int m = 0; m < 4; ++m) _Pragma("unroll") for (int n = 0; n < 2; ++n) _Pragma("unroll") for (int k = 0; k < 2; ++k) \
        { if constexpr (I8) acc[ai][bj][m][n] = __builtin_bit_cast(f32x4, __builtin_amdgcn_mfma_i32_16x16x64_i8(__builtin_bit_cast(i32x4, Bt[n][k]), __builtin_bit_cast(i32x4, At[m][k]), __builtin_bit_cast(i32x4, acc[ai][bj][m][n]), 0, 0, 0)); \
          else acc[ai][bj][m][n] = __builtin_amdgcn_mfma_f32_16x16x32_bf16(Bt[n][k], At[m][k], acc[ai][bj][m][n], 0, 0, 0); } __builtin_amdgcn_s_setprio(0); } while (0)
#define PG8_WAIT_V(n) asm volatile("s_waitcnt vmcnt(" #n ")" ::: "memory")
#define PG8_WAIT_L(n) asm volatile("s_waitcnt lgkmcnt(" #n ")" ::: "memory")
#define PG8_BAR __builtin_amdgcn_s_barrier()
#define PG8_SCHED __builtin_amdgcn_sched_barrier(0)
    Unit cur, nxt; int ui = 0;
    if (!S.next(0, cur)) return;
    f32x4 acc[2][2][4][2];
#pragma unroll
    for (int a = 0; a < 2; ++a)
#pragma unroll
        for (int b = 0; b < 2; ++b)
#pragma unroll
            for (int m = 0; m < 4; ++m)
#pragma unroll
                for (int n = 0; n < 2; ++n) acc[a][b][m][n] = (f32x4){0.f, 0.f, 0.f, 0.f};
    bf16x8 At[4][2], B0[2][2], B1[2][2];
    const char* cA = (const char*)g.A + (size_t)cur.pm * tstep; const char* cB = (const char*)g.Bt + (size_t)cur.pn * tstep;
    S.a_ready(cur);
    PG8_STAGE(PG8_SB(0, 0), cB, voffB); PG8_STAGE(PG8_SA(0, 0), cA, voffA); PG8_STAGE(PG8_SB(0, 1), cB + hstep, voffB); PG8_STAGE(PG8_SA(0, 1), cA + hstep, voffA);
    if (wr == 1) PG8_BAR;
    PG8_WAIT_V(4); PG8_BAR;
    PG8_STAGE(PG8_SB(1, 0), cB + kstep, voffB); PG8_STAGE(PG8_SA(1, 0), cA + kstep, voffA); PG8_STAGE(PG8_SB(1, 1), cB + hstep + kstep, voffB);
    PG8_WAIT_V(6); PG8_BAR;
    PG8_STAMP();
    for (;;) {
        const bool has_next = S.next(ui + 1, nxt);
        const char* nA = has_next ? (const char*)g.A + (size_t)nxt.pm * tstep : cA; const char* nB = has_next ? (const char*)g.Bt + (size_t)nxt.pn * tstep : cB;
        for (int t = 0; t < nt; t += 2) {
            const bool last = (t == nt - 2);
            const char* a1 = cA + (size_t)(t + 1) * kstep;
            const char* a2 = last ? nA : cA + (size_t)(t + 2) * kstep; const char* b2 = last ? nB : cB + (size_t)(t + 2) * kstep;
            const char* a3 = a2 + kstep; const char* b3 = b2 + kstep;
            if (last && has_next) S.a_ready(nxt);
            PG8_LDB(B0, 0, 0); PG8_SCHED; PG8_LDA(At, 0, 0); PG8_STAGE(PG8_SA(1, 1), a1 + hstep, voffA);
            PG8_WAIT_L(8); PG8_BAR; PG8_WAIT_L(0); PG8_MMA(0, 0, At, B0); PG8_BAR; PG8_SCHED;
            PG8_LDB(B1, 0, 1); PG8_STAGE(PG8_SB(0, 0), b2, voffB);
            PG8_BAR; PG8_WAIT_L(0); PG8_MMA(0, 1, At, B1); PG8_BAR;
            PG8_LDA(At, 0, 1); PG8_STAGE(PG8_SA(0, 0), a2, voffA);
            PG8_BAR; PG8_WAIT_L(0); PG8_MMA(1, 0, At, B0); PG8_BAR; PG8_SCHED;
            PG8_STAGE(PG8_SB(0, 1), b2 + hstep, voffB);
            PG8_WAIT_V(6); PG8_BAR; PG8_MMA(1, 1, At, B1); PG8_BAR;
            PG8_LDB(B0, 1, 0); PG8_SCHED; PG8_LDA(At, 1, 0); PG8_STAGE(PG8_SA(0, 1), a2 + hstep, voffA);
            PG8_WAIT_L(8); PG8_BAR; PG8_WAIT_L(0); PG8_MMA(0, 0, At, B0); PG8_BAR; PG8_SCHED;
            PG8_LDB(B1, 1, 1); PG8_STAGE(PG8_SB(1, 0), b3, voffB);
            PG8_BAR; PG8_WAIT_L(0); PG8_MMA(0, 1, At, B1); PG8_BAR;
            PG8_LDA(At, 1, 1); PG8_STAGE(PG8_SA(1, 0), a3, voffA);
            PG8_BAR; PG8_WAIT_L(0); PG8_MMA(1, 0, At, B0); PG8_BAR; PG8_SCHED;
            PG8_STAGE(PG8_SB(1, 1), b3 + hstep, voffB);
            PG8_WAIT_V(6); PG8_BAR; PG8_MMA(1, 1, At, B1); PG8_BAR;
        }
        PG8_STAMP();
        if constexpr (I8) {
#pragma unroll
            for (int a = 0; a < 2; ++a)
#pragma unroll
                for (int b = 0; b < 2; ++b)
#pragma unroll
                    for (int m = 0; m < 4; ++m)
#pragma unroll
                        for (int n = 0; n < 2; ++n) { const i32x4 q = __builtin_bit_cast(i32x4, acc[a][b][m][n]); acc[a][b][m][n] = (f32x4){(float)q.x, (float)q.y, (float)q.z, (float)q.w}; }
        }
        if constexpr (!Epi::AFTER_DRAIN) { E(acc, cur, wr, wc, fr, fq); S.done(cur); }
        PG8_STAMP();
        if (!has_next) break;
#pragma unroll
        for (int a = 0; a < 2; ++a)
#pragma unroll
            for (int b = 0; b < 2; ++b)
#pragma unroll
                for (int m = 0; m < 4; ++m)
#pragma unroll
                    for (int n = 0; n < 2; ++n) acc[a][b][m][n] = (f32x4){0.f, 0.f, 0.f, 0.f};
        cur = nxt; cA = nA; cB = nB; ++ui;
    }
    PG8_WAIT_V(0);
    if (wr == 0) PG8_BAR;
    PG8_BAR;
    if constexpr (Epi::AFTER_DRAIN) { E.fused(acc, cur, wr, wc, fr, fq, lds, wid, lane); S.done(cur); }
    PG8_STAMP();
    if (STAMP && wid == 0) { stamps[lane] = lane < nts ? (((unsigned long long)(unsigned)ts_hi << 32) | (unsigned)ts_lo) : 0ull;
        if (lane == 62) stamps[62] = rt_entry; if (lane == 63) stamps[63] = (unsigned long long)wall_clock64(); }
#undef PG8_STAMP
#undef PG8_SA
#undef PG8_SB
#undef PG8_STAGE
#undef PG8_LDA
#undef PG8_LDB
#undef PG8_MMA
#undef PG8_WAIT_V
#undef PG8_WAIT_L
#undef PG8_BAR
#undef PG8_SCHED
}
}

#ifndef ONE_LAUNCH
#define ONE_LAUNCH 1
#endif
#ifndef PROBE_G
#define PROBE_G 0
#endif
#ifndef PROBE_M
#define PROBE_M 0
#endif
#ifndef PROBE_P
#define PROBE_P 0
#endif
#ifndef PROBE_S
#define PROBE_S 0
#endif
#ifndef PROBE_A
#define PROBE_A 0
#endif
#ifndef PROBE_N
#define PROBE_N 0
#endif
#ifndef PROBE_L
#define PROBE_L 0
#endif
#ifndef PROBE_O
#define PROBE_O 0
#endif
#ifndef PROBE_PH
#define PROBE_PH -1
#endif
constexpr int NWAVES = 8, NTHR = 512;
constexpr int M_TOK = 49152, DM = 1024, SEQL = 2048, NSEQ = 24;
constexpr int CH_SEQ = 8, CH_ROWS = CH_SEQ * SEQL, NCHUNK = 3;
constexpr int QKV_N = 9216, NEXP = 16384, PQ_N = 2048, PLE_K = 256;
constexpr float DN_ALPHA = 1.681792830507429f, LN_EPS = 1e-5f;
constexpr float QSCALE = 0.12751743082459868f;
constexpr int N_PHASES = 1 + 2 * (7 + 5) + 2 * (2 + 5) ;

constexpr size_t MiB = 1u << 20;
constexpr size_t WS_CTL = 0, CTL_ZERO_BYTES = 65536;
constexpr size_t WS_WQKV = 1 * MiB, WS_WO = 37 * MiB, WS_WCIN = 41 * MiB, WS_WCOUT = 53 * MiB, WS_WPQ = 57 * MiB, WS_SK = 73 * MiB, WS_WPP = 75 * MiB, WS_WG = 77 * MiB;
constexpr size_t WS_ROPE = 85 * MiB, WS_U = 86 * MiB, WS_V = 214 * MiB, WS_PB = 342 * MiB, WS_A1 = 438 * MiB, WS_A2 = 534 * MiB, WS_R1 = 630 * MiB, WS_R2 = 918 * MiB, WS_END = 1016 * MiB;
constexpr size_t WS_A3 = WS_V;
constexpr size_t WS_USC = WS_ROPE + 256 * 1024, WS_VSC = WS_ROPE + 512 * 1024;
constexpr size_t R1_H = 0, R1_GB = 96 * MiB, R1_QP = 0, R1_PP = 192 * MiB;
constexpr size_t WS_A3Q = 160 * MiB;
constexpr size_t WS_A1Q = WS_R2 + 50 * MiB;
constexpr size_t WS_SA1 = 128 * 1024, WS_SA3 = 384 * 1024;
constexpr size_t WS_A2Q = 214 * MiB;
constexpr size_t WS_WSQKV = 704 * 1024, WS_WSCIN = 800 * 1024;
constexpr size_t WS_WSPQ = 832 * 1024;
constexpr float ACT_Q = 25.0f, ACT_S = 0.04f;
constexpr size_t WS_WSC = 640 * 1024;
constexpr size_t R2_OG = 0, R2_LSE = 96 * MiB, R2_SEL = 0;
constexpr int CW_BAR = 1024;

constexpr int SCR_BYTES = 152064, MISC_OFF = SCR_BYTES, LDS_BYTES = SCR_BYTES + 512;

#define GAS __attribute__((address_space(1)))
#define LAS __attribute__((address_space(3)))
typedef unsigned short bf16;
typedef unsigned v4u __attribute__((ext_vector_type(4)));
typedef unsigned v2u __attribute__((ext_vector_type(2)));
typedef float f32x4 __attribute__((ext_vector_type(4)));
typedef float f32x2 __attribute__((ext_vector_type(2)));
typedef short bf16x8 __attribute__((ext_vector_type(8)));
typedef __bf16 bf16x2_t __attribute__((ext_vector_type(2)));

__device__ __forceinline__ unsigned f2bf(float f) { unsigned u = __builtin_bit_cast(unsigned, f); return (u + 0x7fffu + ((u >> 16) & 1u)) >> 16; }
__device__ __forceinline__ unsigned pk2(float lo, float hi) { unsigned r; asm("v_cvt_pk_bf16_f32 %0, %1, %2" : "=v"(r) : "v"(lo), "v"(hi)); return r; }
__device__ __forceinline__ float bflo(unsigned w) { return __builtin_bit_cast(float, w << 16); }
__device__ __forceinline__ float bfhi(unsigned w) { return __builtin_bit_cast(float, w & 0xffff0000u); }
__device__ __forceinline__ float dot2bf(unsigned a, unsigned b, float acc) { return __builtin_amdgcn_fdot2_f32_bf16(__builtin_bit_cast(bf16x2_t, a), __builtin_bit_cast(bf16x2_t, b), acc, false); }
__device__ __forceinline__ float wave_sum(float v) {
#pragma unroll
    for (int o = 1; o < 64; o <<= 1) v += __shfl_xor(v, o);
    return v;
}
__device__ __forceinline__ float wave_max(float v) {
#pragma unroll
    for (int o = 1; o < 64; o <<= 1) v = fmaxf(v, __shfl_xor(v, o));
    return v;
}
__device__ __forceinline__ float row_scale_i8(const float (&v)[16], float& inv) {
    float ax = 0.f;
#pragma unroll
    for (int e = 0; e < 16; ++e) ax = fmaxf(ax, fabsf(v[e]));
    ax = wave_max(ax);
    const float sc = ax > 0.f ? ax * (1.0f / 127.0f) : 1.0f; inv = 1.0f / sc; return sc;
}
__device__ __forceinline__ unsigned pack4_i8_sat(float a, float b, float c, float d, float inv) {
    const int q0 = (int)rintf(fminf(fmaxf(a * inv, -127.f), 127.f)), q1 = (int)rintf(fminf(fmaxf(b * inv, -127.f), 127.f)), q2 = (int)rintf(fminf(fmaxf(c * inv, -127.f), 127.f)), q3 = (int)rintf(fminf(fmaxf(d * inv, -127.f), 127.f));
    return (unsigned)(q0 & 0xff) | ((unsigned)(q1 & 0xff) << 8) | ((unsigned)(q2 & 0xff) << 16) | ((unsigned)q3 << 24);
}
__device__ __forceinline__ unsigned pack4_i8(float a, float b, float c, float d, float inv) {
    const int q0 = (int)rintf(a * inv), q1 = (int)rintf(b * inv), q2 = (int)rintf(c * inv), q3 = (int)rintf(d * inv);
    return (unsigned)(q0 & 0xff) | ((unsigned)(q1 & 0xff) << 8) | ((unsigned)(q2 & 0xff) << 16) | ((unsigned)q3 << 24);
}

#define XB_TMO      128
#define XB_XCNT(j)  (256  + 64 * (j))
#define XB_XSUB(j)  (1280 + 64 * (j))
#define XB_XGEN(j)  (2304 + 64 * (j))
#define XB_TOP      3328
#define XB_TOPGEN   3392
#define XCD_BAR_WORDS 3456
#define XB_SPIN_CAP (1u << 21)
__device__ __forceinline__ unsigned xb_ld(unsigned* p)              { return __hip_atomic_load(p, __ATOMIC_RELAXED, __HIP_MEMORY_SCOPE_AGENT); }
__device__ __forceinline__ unsigned xb_add(unsigned* p, unsigned v) { return __hip_atomic_fetch_add(p, v, __ATOMIC_RELAXED, __HIP_MEMORY_SCOPE_AGENT); }
__device__ __forceinline__ unsigned xb_xcc_id() { return (unsigned)__builtin_amdgcn_s_getreg((3 << 11) | 20) & 0xFu; }
#define XB_SPIN(cond, bar) do { unsigned _sp = 0; while (cond) { __builtin_amdgcn_s_sleep(1); \
    if ((++_sp & 255u) == 0u) { if (xb_ld(&(bar)[XB_TMO])) break; if (_sp > XB_SPIN_CAP) { atomicAdd(&(bar)[XB_TMO], 1u); break; } } } } while (0)
struct XcdBarrier { unsigned* bar; unsigned x; volatile LAS unsigned* st; };
__device__ __forceinline__ XcdBarrier xcd_barrier_post(unsigned* bar, volatile LAS unsigned* st) {
    XcdBarrier b; b.bar = bar; b.x = xb_xcc_id(); b.st = st;
    if (threadIdx.x == 0) (void)xb_add(&bar[XB_XCNT(b.x)], 1u);
    return b;
}
__device__ __forceinline__ void xcd_barrier_complete(unsigned* bar, unsigned x, unsigned& nloc, unsigned& nx) {
    const unsigned G = gridDim.x * gridDim.y * gridDim.z;
    unsigned sum, cnt, mine, sp = 0u;
    for (;;) {
        sum = 0u; cnt = 0u; mine = 0u;
#pragma unroll
        for (unsigned j = 0; j < 16; ++j) { const unsigned c = xb_ld(&bar[XB_XCNT(j)]); sum += c; cnt += (c > 0u) ? 1u : 0u; mine = (j == x) ? c : mine; }
        if (sum == G) break;
        __builtin_amdgcn_s_sleep(1);
        if ((++sp & 255u) == 0u) { if (xb_ld(&bar[XB_TMO])) break; if (sp > XB_SPIN_CAP) { atomicAdd(&bar[XB_TMO], 1u); break; } }
    }
    nloc = mine > 0u ? mine : 1u; nx = cnt > 0u ? cnt : 1u;
}
__device__ __forceinline__ void xcd_barrier(const XcdBarrier& b) {
    asm volatile("s_waitcnt vmcnt(0)" ::: "memory");
    __syncthreads();
    if (threadIdx.x == 0) {
        unsigned* bar = b.bar;
        __builtin_amdgcn_s_waitcnt(0);
        unsigned nloc = b.st[0], nx = b.st[1];
        if (nloc == 0u) { xcd_barrier_complete(bar, b.x, nloc, nx); b.st[0] = nloc; b.st[1] = nx; }
        const unsigned old = xb_add(&bar[XB_XSUB(b.x)], 1u);
        const unsigned gen = old / nloc;
        if (old + 1u == (gen + 1u) * nloc) {
            __builtin_amdgcn_fence(__ATOMIC_RELEASE, "agent");
            asm volatile("s_waitcnt vmcnt(0)" ::: "memory");
            const unsigned og = xb_add(&bar[XB_TOP], 1u);
            const unsigned tg = og / nx;
            if (og + 1u == (tg + 1u) * nx) xb_add(&bar[XB_TOPGEN], 1u);
            else XB_SPIN(xb_ld(&bar[XB_TOPGEN]) == tg, bar);
            __builtin_amdgcn_fence(__ATOMIC_ACQUIRE, "agent");
            xb_add(&bar[XB_XGEN(b.x)], 1u);
            asm volatile("s_waitcnt vmcnt(0)" ::: "memory");
        } else {
            XB_SPIN(xb_ld(&bar[XB_XGEN(b.x)]) == gen, bar);
            __builtin_amdgcn_fence(__ATOMIC_ACQUIRE, "agent");
            asm volatile("s_waitcnt vmcnt(0)" ::: "memory");
        }
    }
    __syncthreads();
}

struct EpiResid {
    static constexpr bool PERM = true, AFTER_DRAIN = false;
    const bf16* XR; bf16* Z; const float* SA; const float* SB;
    __device__ __forceinline__ void operator()(const f32x4 (&acc)[2][2][4][2], const pg8::Unit& u, int wr, int wc, int fr, int fq) const {
        const int row0 = u.pm * 256 + wr * 64 + fr, col0 = u.pn * 256 + wc * 32 + 8 * fq;
        f32x4 sbv[2][2];
#pragma unroll
        for (int bj = 0; bj < 2; ++bj) { sbv[bj][0] = *(const f32x4*)(SB + col0 + bj * 128); sbv[bj][1] = *(const f32x4*)(SB + col0 + bj * 128 + 4); }
#pragma unroll
        for (int ai = 0; ai < 2; ++ai) {
            v4u xv[4][2]; float sr[4];
#pragma unroll
            for (int m = 0; m < 4; ++m) { sr[m] = SA[row0 + ai * 128 + m * 16];
#pragma unroll
                for (int bj = 0; bj < 2; ++bj) xv[m][bj] = *(const v4u*)(XR + (size_t)(row0 + ai * 128 + m * 16) * DM + col0 + bj * 128); }
#pragma unroll
            for (int m = 0; m < 4; ++m)
#pragma unroll
                for (int bj = 0; bj < 2; ++bj) { const v4u x = xv[m][bj]; const f32x4 a0 = acc[ai][bj][m][0] * (sbv[bj][0] * sr[m]), a1 = acc[ai][bj][m][1] * (sbv[bj][1] * sr[m]); v4u w;
                    w.x = pk2(bflo(x.x) * DN_ALPHA + a0.x, bfhi(x.x) * DN_ALPHA + a0.y); w.y = pk2(bflo(x.y) * DN_ALPHA + a0.z, bfhi(x.y) * DN_ALPHA + a0.w);
                    w.z = pk2(bflo(x.z) * DN_ALPHA + a1.x, bfhi(x.z) * DN_ALPHA + a1.y); w.w = pk2(bflo(x.w) * DN_ALPHA + a1.z, bfhi(x.w) * DN_ALPHA + a1.w);
                    *(v4u*)(Z + (size_t)(row0 + ai * 128 + m * 16) * DM + col0 + bj * 128) = w; }
        }
    }
};
struct EpiGate {
    static constexpr bool PERM = true, AFTER_DRAIN = false;
    const bf16* XR; const bf16* PP; bf16* XB; float* OUT; const float* SA; const float* SB; unsigned char* XQ;
    __device__ __forceinline__ void operator()(const f32x4 (&acc)[2][2][4][2], const pg8::Unit& u, int wr, int wc, int fr, int fq) const {
        const int row0 = u.pm * 256 + wr * 64 + fr, col0 = u.pn * 256 + wc * 32 + 8 * fq;
        f32x4 sbv[2][2];
#pragma unroll
        for (int bj = 0; bj < 2; ++bj) { sbv[bj][0] = *(const f32x4*)(SB + col0 + bj * 128); sbv[bj][1] = *(const f32x4*)(SB + col0 + bj * 128 + 4); }
#pragma unroll
        for (int ai = 0; ai < 2; ++ai)
#pragma unroll
        for (int mh = 0; mh < 2; ++mh) {
            v4u xv[2][2], pv[2][2]; float sr[2];
#pragma unroll
            for (int mm = 0; mm < 2; ++mm) { const int m = 2 * mh + mm; sr[mm] = SA[row0 + ai * 128 + m * 16];
#pragma unroll
                for (int bj = 0; bj < 2; ++bj) { const size_t o = (size_t)(row0 + ai * 128 + m * 16) * DM + col0 + bj * 128; xv[mm][bj] = *(const v4u*)(XR + o); pv[mm][bj] = *(const v4u*)(PP + o); } }
#pragma unroll
            for (int mm = 0; mm < 2; ++mm)
#pragma unroll
                for (int bj = 0; bj < 2; ++bj) { const int m = 2 * mh + mm; const size_t o = (size_t)(row0 + ai * 128 + m * 16) * DM + col0 + bj * 128; const v4u x = xv[mm][bj], p2 = pv[mm][bj];
                    const f32x4 a0 = acc[ai][bj][m][0] * (sbv[bj][0] * sr[mm]), a1 = acc[ai][bj][m][1] * (sbv[bj][1] * sr[mm]);
                    float r[8];
#define SG_(pv, av) ((pv) * __builtin_amdgcn_rcpf(1.0f + __builtin_amdgcn_exp2f((av) * -1.44269504089f)))
                    r[0] = bflo(x.x) + SG_(bflo(p2.x), a0.x); r[1] = bfhi(x.x) + SG_(bfhi(p2.x), a0.y); r[2] = bflo(x.y) + SG_(bflo(p2.y), a0.z); r[3] = bfhi(x.y) + SG_(bfhi(p2.y), a0.w);
                    r[4] = bflo(x.z) + SG_(bflo(p2.z), a1.x); r[5] = bfhi(x.z) + SG_(bfhi(p2.z), a1.y); r[6] = bflo(x.w) + SG_(bflo(p2.w), a1.z); r[7] = bfhi(x.w) + SG_(bfhi(p2.w), a1.w);
#undef SG_
                    if (OUT) { *(f32x4*)(OUT + o) = (f32x4){r[0], r[1], r[2], r[3]}; *(f32x4*)(OUT + o + 4) = (f32x4){r[4], r[5], r[6], r[7]}; }
                    else { v4u w; w.x = pk2(r[0], r[1]); w.y = pk2(r[2], r[3]); w.z = pk2(r[4], r[5]); w.w = pk2(r[6], r[7]); *(v4u*)(XB + o) = w;
                           v2u q2; q2.x = pack4_i8_sat(r[0], r[1], r[2], r[3], ACT_Q); q2.y = pack4_i8_sat(r[4], r[5], r[6], r[7], ACT_Q); *(v2u*)(XQ + o) = q2; } }
        }
    }
};
struct EpiCin {
    static constexpr bool PERM = true, AFTER_DRAIN = false;
    bf16* H; bf16* GB; const float* SB;
    __device__ __forceinline__ void operator()(const f32x4 (&acc_)[2][2][4][2], const pg8::Unit& u, int wr, int wc, int fr, int fq) const {
        const int row0 = u.pm * 256 + wr * 64 + fr;
        f32x4 acc[2][2][4][2];
        {   const int cg = u.pn * 256 + wc * 32 + 8 * fq;
#pragma unroll
            for (int bj = 0; bj < 2; ++bj) { const f32x4 s0 = *(const f32x4*)(SB + cg + bj * 128) * ACT_S, s1 = *(const f32x4*)(SB + cg + bj * 128 + 4) * ACT_S;
#pragma unroll
                for (int ai = 0; ai < 2; ++ai)
#pragma unroll
                    for (int m = 0; m < 4; ++m) { acc[ai][bj][m][0] = acc_[ai][bj][m][0] * s0; acc[ai][bj][m][1] = acc_[ai][bj][m][1] * s1; } } }
        if (u.pn < 8) {
            const int c0 = u.pn * 128 + wc * 32 + 8 * fq;
#pragma unroll
            for (int ai = 0; ai < 2; ++ai)
#pragma unroll
                for (int m = 0; m < 4; ++m) { const f32x4 g0 = acc[ai][0][m][0], g1 = acc[ai][0][m][1], x0 = acc[ai][1][m][0], x1 = acc[ai][1][m][1];
                    v4u w; w.x = pk2(g0.x * x0.x, g0.y * x0.y); w.y = pk2(g0.z * x0.z, g0.w * x0.w); w.z = pk2(g1.x * x1.x, g1.y * x1.y); w.w = pk2(g1.z * x1.z, g1.w * x1.w);
                    *(v4u*)(H + (size_t)(row0 + ai * 128 + m * 16) * DM + c0) = w; }
        } else {
            const int c0 = (u.pn - 8) * 256 + wc * 32 + 8 * fq;
#pragma unroll
            for (int ai = 0; ai < 2; ++ai)
#pragma unroll
                for (int m = 0; m < 4; ++m)
#pragma unroll
                    for (int bj = 0; bj < 2; ++bj) { const f32x4 v0 = acc[ai][bj][m][0], v1 = acc[ai][bj][m][1];
                        v4u w; w.x = pk2(v0.x, v0.y); w.y = pk2(v0.z, v0.w); w.z = pk2(v1.x, v1.y); w.w = pk2(v1.z, v1.w);
                        *(v4u*)(GB + (size_t)(row0 + ai * 128 + m * 16) * DM + c0 + bj * 128) = w; }
        }
    }
};
struct EpiQKV {
    static constexpr bool PERM = true, AFTER_DRAIN = false;
    bf16* P; const f32x2* rope; const float* SB;
    __device__ __forceinline__ void operator()(const f32x4 (&acc)[2][2][4][2], const pg8::Unit& u, int wr, int wc, int fr, int fq) const {
        const int g = u.pn / 12, t = (u.pn % 12) >> 2, hp = u.pn & 3;
        f32x4 sv[2][2];
        {   const float k_ = ((t == 0) ? QSCALE : 1.0f) * ACT_S; const int cg = u.pn * 256 + wc * 32 + 8 * fq;
#pragma unroll
            for (int bj = 0; bj < 2; ++bj) { sv[bj][0] = *(const f32x4*)(SB + cg + bj * 128) * k_; sv[bj][1] = *(const f32x4*)(SB + cg + bj * 128 + 4) * k_; } }
        const int sq = u.pm >> 3;
        const int tok0 = (u.pm & 7) * 256 + wr * 64 + fr;
        const int d0 = wc * 32 + 8 * fq;
        const bool rot = (t < 2) && (wc == 0);
        float co[8], si[8], c16[8], s16[8], c80[8], s80[8];
        if (rot) {
            const f32x4* r0 = (const f32x4*)(rope + tok0 * 16 + 8 * (fq & 1)); const f32x4* r16 = (const f32x4*)(rope + 16 * 16 + 8 * (fq & 1)); const f32x4* r80 = (const f32x4*)(rope + 80 * 16 + 8 * (fq & 1));
#pragma unroll
            for (int q = 0; q < 4; ++q) { const f32x4 a = r0[q], b = r16[q], c = r80[q];
                co[2 * q] = a.x; si[2 * q] = a.y; co[2 * q + 1] = a.z; si[2 * q + 1] = a.w; c16[2 * q] = b.x; s16[2 * q] = b.y; c16[2 * q + 1] = b.z; s16[2 * q + 1] = b.w; c80[2 * q] = c.x; s80[2 * q] = c.y; c80[2 * q + 1] = c.z; s80[2 * q + 1] = c.w; }
        }
#pragma unroll
        for (int ai = 0; ai < 2; ++ai)
#pragma unroll
            for (int m = 0; m < 4; ++m) {
                const int tok = tok0 + ai * 128 + m * 16;
#pragma unroll
                for (int bj = 0; bj < 2; ++bj) {
                    float v[8];
#pragma unroll
                    for (int n = 0; n < 2; ++n) { const f32x4 a = acc[ai][bj][m][n] * sv[bj][n]; v[4 * n] = a.x; v[4 * n + 1] = a.y; v[4 * n + 2] = a.z; v[4 * n + 3] = a.w; }
                    if (rot) {
#pragma unroll
                        for (int e = 0; e < 8; ++e) { const auto sw = __builtin_amdgcn_permlane32_swap(__builtin_bit_cast(unsigned, v[e]), __builtin_bit_cast(unsigned, v[e]), false, false);
                            const float pr = __builtin_bit_cast(float, (fq < 2) ? sw[1] : sw[0]); v[e] = (fq < 2) ? (v[e] * co[e] - pr * si[e]) : (v[e] * co[e] + pr * si[e]); }
                    }
                    const int h = 2 * hp + bj;
                    const size_t plane = (size_t)(((sq * 3 + g) * 3 + t) * 8 + h);
                    if (t == 2) {
                        v2u w8; int q_ = 0; q_ = __builtin_amdgcn_cvt_pk_fp8_f32(v[0], v[1], q_, false); q_ = __builtin_amdgcn_cvt_pk_fp8_f32(v[2], v[3], q_, true); w8.x = (unsigned)q_;
                        q_ = 0; q_ = __builtin_amdgcn_cvt_pk_fp8_f32(v[4], v[5], q_, false); q_ = __builtin_amdgcn_cvt_pk_fp8_f32(v[6], v[7], q_, true); w8.y = (unsigned)q_;
                        *(v2u*)((unsigned char*)(P + plane * SEQL * 128) + (size_t)tok * 128 + d0) = w8;
                    } else {
                    v4u w; w.x = pk2(v[0], v[1]); w.y = pk2(v[2], v[3]); w.z = pk2(v[4], v[5]); w.w = pk2(v[6], v[7]);
                    *(v4u*)(P + (plane * SEQL + tok) * 128 + d0) = w; }
                }
                if (rot && !(ai == 1 && m == 3)) {
#pragma unroll
                    for (int e = 0; e < 8; ++e) { const float cd = (m < 3) ? c16[e] : c80[e], sd = (m < 3) ? s16[e] : s80[e]; const float cn = co[e] * cd - si[e] * sd, sn = si[e] * cd + co[e] * sd; co[e] = cn; si[e] = sn; }
                }
            }
    }
};
struct EpiQp {
    static constexpr bool PERM = true, AFTER_DRAIN = false;
    bf16* O; const float* SA; const float* SB;
    __device__ __forceinline__ void operator()(const f32x4 (&acc)[2][2][4][2], const pg8::Unit& u, int wr, int wc, int fr, int fq) const {
        const int row0 = u.pm * 256 + wr * 64 + fr, col0 = u.pn * 256 + wc * 32 + 8 * fq;
        f32x4 sbv[2][2];
#pragma unroll
        for (int bj = 0; bj < 2; ++bj) { sbv[bj][0] = *(const f32x4*)(SB + col0 + bj * 128); sbv[bj][1] = *(const f32x4*)(SB + col0 + bj * 128 + 4); }
#pragma unroll
        for (int ai = 0; ai < 2; ++ai)
#pragma unroll
            for (int m = 0; m < 4; ++m) { const float sr = SA[row0 + ai * 128 + m * 16];
#pragma unroll
                for (int bj = 0; bj < 2; ++bj) { const f32x4 a0 = acc[ai][bj][m][0] * (sbv[bj][0] * sr), a1 = acc[ai][bj][m][1] * (sbv[bj][1] * sr);
                    v4u w; w.x = pk2(a0.x, a0.y); w.y = pk2(a0.z, a0.w); w.z = pk2(a1.x, a1.y); w.w = pk2(a1.z, a1.w);
                    *(v4u*)(O + (size_t)(row0 + ai * 128 + m * 16) * PQ_N + col0 + bj * 128) = w; } }
    }
};
struct EpiNull {
    static constexpr bool PERM = true, AFTER_DRAIN = false;
    __device__ __forceinline__ void operator()(const f32x4 (&acc)[2][2][4][2], const pg8::Unit&, int, int, int, int) const {
#pragma unroll
        for (int a = 0; a < 2; ++a)
#pragma unroll
            for (int b = 0; b < 2; ++b)
#pragma unroll
                for (int m = 0; m < 4; ++m)
#pragma unroll
                    for (int n = 0; n < 2; ++n) asm volatile("" :: "v"(acc[a][b][m][n]));
    }
};
struct Args { const float* in[19]; float* out; unsigned char* ws; float inv_freq[16]; int ph_lo, ph_hi; };

__device__ __forceinline__ void transpose_item(const float* W, int K, int N, bf16* WT, int k0, int n0, int drow0, LAS float* scr, int lane) {
#pragma unroll 8
    for (int i = 0; i < 32; ++i) { const int kk = 2 * i + (lane >> 5); scr[kk * 33 + (lane & 31)] = W[(size_t)(k0 + kk) * N + n0 + (lane & 31)]; }
    asm volatile("s_waitcnt lgkmcnt(0)" ::: "memory");
    const int c = lane & 7;
#pragma unroll
    for (int j = 0; j < 4; ++j) { const int n = (lane >> 3) + 8 * j; const LAS float* s = scr + (8 * c) * 33 + n;
        v4u o; o.x = pk2(s[0 * 33], s[1 * 33]); o.y = pk2(s[2 * 33], s[3 * 33]); o.z = pk2(s[4 * 33], s[5 * 33]); o.w = pk2(s[6 * 33], s[7 * 33]);
        *(v4u*)(WT + (size_t)(drow0 + n) * K + k0 + 8 * c) = o; }
    asm volatile("s_waitcnt lgkmcnt(0)" ::: "memory");
}
__device__ __forceinline__ void cvt_range(const float* src, bf16* dst, size_t n8, size_t g0, size_t gs) {
    size_t i = g0;
    for (; i + 3 * gs < n8; i += 4 * gs) {
        f32x4 a[4], b[4];
#pragma unroll
        for (int q = 0; q < 4; ++q) { a[q] = ((const f32x4*)src)[2 * (i + q * gs)]; b[q] = ((const f32x4*)src)[2 * (i + q * gs) + 1]; }
#pragma unroll
        for (int q = 0; q < 4; ++q) { v4u o; o.x = pk2(a[q].x, a[q].y); o.y = pk2(a[q].z, a[q].w); o.z = pk2(b[q].x, b[q].y); o.w = pk2(b[q].z, b[q].w); ((v4u*)dst)[i + q * gs] = o; }
    }
    for (; i < n8; i += gs) { const f32x4 a = ((const f32x4*)src)[2 * i], b = ((const f32x4*)src)[2 * i + 1];
        v4u o; o.x = pk2(a.x, a.y); o.y = pk2(a.z, a.w); o.z = pk2(b.x, b.y); o.w = pk2(b.z, b.w); ((v4u*)dst)[i] = o; }
}
__device__ __forceinline__ void cvt_copy_range(const float* src, bf16* dst, float* cpy, size_t n8, size_t g0, size_t gs) {
    size_t i = g0;
    for (; i + 3 * gs < n8; i += 4 * gs) {
        f32x4 a[4], b[4];
#pragma unroll
        for (int q = 0; q < 4; ++q) { a[q] = ((const f32x4*)src)[2 * (i + q * gs)]; b[q] = ((const f32x4*)src)[2 * (i + q * gs) + 1]; }
#pragma unroll
        for (int q = 0; q < 4; ++q) { v4u o; o.x = pk2(a[q].x, a[q].y); o.y = pk2(a[q].z, a[q].w); o.z = pk2(b[q].x, b[q].y); o.w = pk2(b[q].z, b[q].w); ((v4u*)dst)[i + q * gs] = o;
            ((f32x4*)cpy)[2 * (i + q * gs)] = a[q]; ((f32x4*)cpy)[2 * (i + q * gs) + 1] = b[q]; }
    }
    for (; i < n8; i += gs) { const f32x4 a = ((const f32x4*)src)[2 * i], b = ((const f32x4*)src)[2 * i + 1];
        v4u o; o.x = pk2(a.x, a.y); o.y = pk2(a.z, a.w); o.z = pk2(b.x, b.y); o.w = pk2(b.z, b.w); ((v4u*)dst)[i] = o; ((f32x4*)cpy)[2 * i] = a; ((f32x4*)cpy)[2 * i + 1] = b; }
}
__device__ __forceinline__ void cvt_rows_fp8(const float* src, unsigned char* dst, float* sc, int nrows, int lane, int gw, int NGW) {
    for (int r0 = gw; r0 < nrows; r0 += 4 * NGW) {
        f32x4 v[4][4]; float m[4];
#pragma unroll
        for (int j = 0; j < 4; ++j) { const int r = r0 + j * NGW; const f32x4* p = (const f32x4*)(src + (size_t)(r < nrows ? r : r0) * DM + 16 * lane);
#pragma unroll
            for (int q = 0; q < 4; ++q) v[j][q] = p[q]; }
#pragma unroll
        for (int j = 0; j < 4; ++j) { float mm = 0.f;
#pragma unroll
            for (int q = 0; q < 4; ++q) mm = fmaxf(mm, fmaxf(fmaxf(fabsf(v[j][q].x), fabsf(v[j][q].y)), fmaxf(fabsf(v[j][q].z), fabsf(v[j][q].w))));
            m[j] = mm; }
#pragma unroll
        for (int o = 1; o < 64; o <<= 1) {
#pragma unroll
            for (int j = 0; j < 4; ++j) m[j] = fmaxf(m[j], __shfl_xor(m[j], o)); }
#pragma unroll
        for (int j = 0; j < 4; ++j) { const int r = r0 + j * NGW; if (r < nrows) {
            const float scale = (m[j] > 0.f) ? 416.0f / m[j] : 1.0f;
            v4u o;
#pragma unroll
            for (int q = 0; q < 4; ++q) { int w = 0; w = __builtin_amdgcn_cvt_pk_fp8_f32(v[j][q].x * scale, v[j][q].y * scale, w, false); w = __builtin_amdgcn_cvt_pk_fp8_f32(v[j][q].z * scale, v[j][q].w * scale, w, true); o[q] = (unsigned)w; }
            *(v4u*)(dst + (size_t)r * DM + 16 * lane) = o;
            if (lane == 0) sc[r] = 1.0f / scale; } }
    }
}
constexpr int T4_ROW = 1152;
__device__ __forceinline__ void quant16_i4(const f32x4 (&v)[4], unsigned& w0, unsigned& w1, unsigned& sc16) {
    float m = 0.f;
#pragma unroll
    for (int q = 0; q < 4; ++q) m = fmaxf(m, fmaxf(fmaxf(fabsf(v[q].x), fabsf(v[q].y)), fmaxf(fabsf(v[q].z), fabsf(v[q].w))));
    const float s1k = fmaxf(m * (1024.0f / 7.5f), 0.015625f);
    sc16 = (unsigned)__builtin_amdgcn_cvt_pk_fp8_f32(s1k, s1k, 0, false) & 0xffu;
    const f32x2 dec = __builtin_amdgcn_cvt_pk_f32_fp8((int)sc16, false);
    const float inv = 1024.0f / dec.x;
    unsigned w[2] = {0u, 0u};
#pragma unroll
    for (int q = 0; q < 4; ++q) { const float e[4] = {v[q].x, v[q].y, v[q].z, v[q].w};
#pragma unroll
        for (int j = 0; j < 4; ++j) { float t = floorf(e[j] * inv + 8.0f); t = fminf(fmaxf(t, 0.f), 15.f); w[q >> 1] |= (unsigned)t << (4 * (4 * (q & 1) + j)); } }
    w0 = w[0]; w1 = w[1];
}
#ifndef FP4_LO_FIRST
#define FP4_LO_FIRST 1
#endif
__device__ __forceinline__ void quant16_fp4(const f32x4 (&v)[4], unsigned& w0, unsigned& w1, unsigned& sc16) {
    float m = 0.f;
#pragma unroll
    for (int q = 0; q < 4; ++q) m = fmaxf(m, fmaxf(fmaxf(fabsf(v[q].x), fabsf(v[q].y)), fmaxf(fabsf(v[q].z), fabsf(v[q].w))));
    const float s1k = fmaxf(m * (1024.0f / 6.0f), 0.015625f);
    sc16 = (unsigned)__builtin_amdgcn_cvt_pk_fp8_f32(s1k, s1k, 0, false) & 0xffu;
    const f32x2 dec = __builtin_amdgcn_cvt_pk_f32_fp8((int)sc16, false);
    const float inv = 1024.0f / dec.x;
    unsigned w[2] = {0u, 0u};
#pragma unroll
    for (int q = 0; q < 4; ++q) { const float e[4] = {v[q].x, v[q].y, v[q].z, v[q].w};
#pragma unroll
        for (int j = 0; j < 4; ++j) { const float y = e[j] * inv, ay = fabsf(y);
            unsigned c = (ay > 0.25f) + (ay > 0.75f) + (ay > 1.25f) + (ay > 1.75f) + (ay > 2.5f) + (ay > 3.5f) + (ay > 5.0f);
            c |= (y < 0.f) ? 8u : 0u;
            const int el = 4 * (q & 1) + j;
            const int nib = FP4_LO_FIRST ? el : (el ^ 1);
            w[q >> 1] |= c << (4 * nib); } }
    w0 = w[0]; w1 = w[1];
}
__device__ __forceinline__ void quant_rows_i4(const float* U, const float* V, unsigned char* dst, int nrows, int lane, int gw, int NGW) {
    for (int r0 = gw; r0 < nrows; r0 += 2 * NGW) {
        f32x4 uv[2][4], vv[2][4];
#pragma unroll
        for (int j = 0; j < 2; ++j) { const int r = (r0 + j * NGW < nrows) ? r0 + j * NGW : r0; const f32x4* pu = (const f32x4*)(U + (size_t)r * DM + 16 * lane); const f32x4* pv = (const f32x4*)(V + (size_t)r * DM + 16 * lane);
#pragma unroll
            for (int q = 0; q < 4; ++q) { uv[j][q] = pu[q]; vv[j][q] = pv[q]; } }
#pragma unroll
        for (int j = 0; j < 2; ++j) { const int r = r0 + j * NGW; if (r < nrows) {
            unsigned u0, u1, v0, v1, su, sv; quant16_i4(uv[j], u0, u1, su); quant16_fp4(vv[j], v0, v1, sv); const v4u o = {u0, u1, v0, v1};
            unsigned char* row = dst + (size_t)r * T4_ROW;
            *((v4u*)row + lane) = o; *((unsigned short*)(row + 1024) + lane) = (unsigned short)(su | (sv << 8)); } }
    }
}
__device__ __forceinline__ void sincos_d(double x, double& s, double& c) {
    const double k = rint(x * 0.15915494309189533576888376337251); const double r = x - k * 6.283185307179586476925286766559; const double r2 = r * r;
    double sp = 1.0, cp = 1.0;
    for (int n = 14; n >= 1; --n) { sp = 1.0 - sp * r2 / ((2.0 * n) * (2.0 * n + 1.0)); cp = 1.0 - cp * r2 / ((2.0 * n - 1.0) * (2.0 * n)); }
    s = r * sp; c = cp;
}
__device__ __forceinline__ void cvt_range_i8(const float* src, unsigned char* dst, size_t n8, size_t g0, size_t gs) {
    for (size_t e = g0; e < n8; e += gs) { const f32x4 a = *((const f32x4*)src + 2 * e), b = *((const f32x4*)src + 2 * e + 1);
        v2u w; w.x = pack4_i8_sat(a.x, a.y, a.z, a.w, ACT_Q); w.y = pack4_i8_sat(b.x, b.y, b.z, b.w, ACT_Q); *((v2u*)dst + e) = w; }
}
__device__ __forceinline__ void prologue(const Args& a, unsigned char* ws, LAS unsigned char* lds, int tid, int lane, int wave, int bid, int G) {
    const int gw = bid * NWAVES + wave, NGW = G * NWAVES;
    LAS float* scr = (LAS float*)(lds + wave * 16384);
    {
        LAS float* red = (LAS float*)(lds + 8 * 16384);
        for (int it = bid; it < 1280; it += G) {
            const float* W; unsigned char* WQ; float* SC; int N, n0, drow0;
            if (it < 576)      { const int m = it / 288, nb = it % 288; N = QKV_N; n0 = 32 * nb; drow0 = n0; W = ((const float*)(const GAS float*)a.in[4]) + (size_t)m * 1024 * QKV_N; WQ = ws + WS_WQKV + (size_t)m * QKV_N * 1024; SC = (float*)(ws + WS_WSQKV) + m * QKV_N; }
            else if (it < 768) { const int m = (it - 576) / 96, nb = (it - 576) % 96; N = 3072; n0 = 32 * nb; const int part = n0 >> 10, c = n0 & 1023; drow0 = (part == 0) ? (2048 + c) : (256 * (c >> 7) + (c & 127) + (part == 2 ? 128 : 0));
                                 W = ((const float*)(const GAS float*)a.in[6]) + (size_t)m * 1024 * 3072; WQ = ws + WS_WCIN + (size_t)m * 3072 * 1024; SC = (float*)(ws + WS_WSCIN) + m * 3072; }
            else if (it >= 1024) { const int m = (it - 1024) >> 6, nb = (it - 1024) & 63; N = PQ_N; n0 = 32 * nb; drow0 = n0; W = ((const float*)(const GAS float*)a.in[9]) + (size_t)m * 1024 * PQ_N; WQ = ws + WS_WPQ + (size_t)m * PQ_N * 1024; SC = (float*)(ws + WS_WSPQ) + m * PQ_N; }
            else               { const int m8 = (it - 768) >> 5; N = 1024; n0 = 32 * ((it - 768) & 31); drow0 = n0; SC = (float*)(ws + WS_WSC) + m8 * 1024;
                                 W = (m8 < 2) ? ((const float*)(const GAS float*)a.in[5]) + (size_t)m8 * 1024 * 1024 : (m8 < 4) ? ((const float*)(const GAS float*)a.in[8]) + (size_t)(m8 - 2) * 1024 * 1024 : ((const float*)(const GAS float*)a.in[18]) + (size_t)(m8 - 4) * 1024 * 1024;
                                 WQ = (m8 < 2) ? ws + WS_WO + (size_t)m8 * 1024 * 1024 : (m8 < 4) ? ws + WS_WCOUT + (size_t)(m8 - 2) * 1024 * 1024 : ws + WS_WG + (size_t)(m8 - 4) * 1024 * 1024; }
            const int ng = lane & 7, kq = lane >> 3, kb = 128 * wave + 16 * kq;
            const float* wp = W + (size_t)kb * N + n0 + 4 * ng;
            f32x4 t[16];
#pragma unroll
            for (int j = 0; j < 16; ++j) t[j] = *(const f32x4*)(wp + (size_t)j * N);
            f32x4 mx = {0.f, 0.f, 0.f, 0.f};
#pragma unroll
            for (int j = 0; j < 16; ++j) { mx.x = fmaxf(mx.x, fabsf(t[j].x)); mx.y = fmaxf(mx.y, fabsf(t[j].y)); mx.z = fmaxf(mx.z, fabsf(t[j].z)); mx.w = fmaxf(mx.w, fabsf(t[j].w)); }
#pragma unroll
            for (int o = 8; o < 64; o <<= 1) { mx.x = fmaxf(mx.x, __shfl_xor(mx.x, o)); mx.y = fmaxf(mx.y, __shfl_xor(mx.y, o)); mx.z = fmaxf(mx.z, __shfl_xor(mx.z, o)); mx.w = fmaxf(mx.w, __shfl_xor(mx.w, o)); }
            if (kq == 0) *(LAS f32x4*)(red + wave * 32 + 4 * ng) = mx;
            __syncthreads();
            f32x4 m4 = {0.f, 0.f, 0.f, 0.f};
#pragma unroll
            for (int w = 0; w < 8; ++w) { const f32x4 r = *(const LAS f32x4*)(red + w * 32 + 4 * ng); m4.x = fmaxf(m4.x, r.x); m4.y = fmaxf(m4.y, r.y); m4.z = fmaxf(m4.z, r.z); m4.w = fmaxf(m4.w, r.w); }
            f32x4 sc4, iv4;
            sc4.x = m4.x > 0.f ? m4.x * (1.0f / 127.0f) : 1.0f; sc4.y = m4.y > 0.f ? m4.y * (1.0f / 127.0f) : 1.0f; sc4.z = m4.z > 0.f ? m4.z * (1.0f / 127.0f) : 1.0f; sc4.w = m4.w > 0.f ? m4.w * (1.0f / 127.0f) : 1.0f;
            iv4.x = 1.0f / sc4.x; iv4.y = 1.0f / sc4.y; iv4.z = 1.0f / sc4.z; iv4.w = 1.0f / sc4.w;
            unsigned char* wq = WQ + (size_t)(drow0 + 4 * ng) * 1024 + kb;
#define WQ_ROW(c, cc) { v4u w; w.x = pack4_i8(t[0].c, t[1].c, t[2].c, t[3].c, iv4.c); w.y = pack4_i8(t[4].c, t[5].c, t[6].c, t[7].c, iv4.c); w.z = pack4_i8(t[8].c, t[9].c, t[10].c, t[11].c, iv4.c); w.w = pack4_i8(t[12].c, t[13].c, t[14].c, t[15].c, iv4.c); *(v4u*)(wq + (cc) * 1024) = w; }
            WQ_ROW(x, 0) WQ_ROW(y, 1) WQ_ROW(z, 2) WQ_ROW(w, 3)
#undef WQ_ROW
            if (wave == 0 && kq == 0) *(f32x4*)(SC + drow0 + 4 * ng) = sc4;
            __syncthreads();
        }
    }
    for (int mi = 0; mi < 20; ++mi) {
        if (mi < 12 || mi >= 16) continue;
        const float* W; bf16* WT; int K = 1024, N = 1024, mode = 0;
        if (mi < 2)       { W = ((const float*)(const GAS float*)a.in[4]) + (size_t)mi * 1024 * QKV_N;          WT = (bf16*)(ws + WS_WQKV) + (size_t)mi * QKV_N * 1024; N = QKV_N; }
        else if (mi < 4)  { W = ((const float*)(const GAS float*)a.in[5]) + (size_t)(mi - 2) * 1024 * 1024;    WT = (bf16*)(ws + WS_WO) + (size_t)(mi - 2) * 1024 * 1024; }
        else if (mi < 6)  { W = ((const float*)(const GAS float*)a.in[6]) + (size_t)(mi - 4) * 1024 * 3072;    WT = (bf16*)(ws + WS_WCIN) + (size_t)(mi - 4) * 3072 * 1024; N = 3072; mode = 1; }
        else if (mi < 8)  { W = ((const float*)(const GAS float*)a.in[8]) + (size_t)(mi - 6) * 1024 * 1024;    WT = (bf16*)(ws + WS_WCOUT) + (size_t)(mi - 6) * 1024 * 1024; }
        else if (mi < 12) { W = ((const float*)(const GAS float*)a.in[9]) + (size_t)(mi - 8) * 1024 * PQ_N;    WT = (bf16*)(ws + WS_WPQ) + (size_t)(mi - 8) * PQ_N * 1024; N = PQ_N; }
        else if (mi < 16) { W = ((const float*)(const GAS float*)a.in[17]) + (size_t)(mi - 12) * PLE_K * 1024; WT = (bf16*)(ws + WS_WPP) + (size_t)(mi - 12) * 1024 * PLE_K; K = PLE_K; }
        else              { W = ((const float*)(const GAS float*)a.in[18]) + (size_t)(mi - 16) * 1024 * 1024;  WT = (bf16*)(ws + WS_WG) + (size_t)(mi - 16) * 1024 * 1024; }
        const int nblk = N / 32, nitems = (K / 64) * nblk;
        for (int it = gw; it < nitems; it += NGW) {
            const int kb = it / nblk, nb = it % nblk, n0 = 32 * nb;
            int drow0 = n0;
            if (mode == 1) {
                const int part = n0 >> 10, c = n0 & 1023;
                drow0 = (part == 0) ? (2048 + c) : (256 * (c >> 7) + (c & 127) + (part == 2 ? 128 : 0));
            }
            transpose_item(W, K, N, WT, 64 * kb, n0, drow0, scr, lane);
        }
    }
    const size_t g0 = (size_t)bid * NTHR + tid, gs = (size_t)G * NTHR;
    cvt_range(((const float*)(const GAS float*)a.in[10]), (bf16*)(ws + WS_SK), (size_t)4 * 8 * 2 * 128 * 128 / 8, g0, gs);
    quant_rows_i4(((const float*)(const GAS float*)a.in[11]), ((const float*)(const GAS float*)a.in[12]), ws + WS_U, 4 * NEXP, lane, gw, NGW);
    for (int i = 0; i < 4; ++i) {
        cvt_range(((const float*)(const GAS float*)a.in[2]) + (size_t)i * 16384 * PLE_K, (bf16*)(ws + WS_PB) + (size_t)i * M_TOK * PLE_K, (size_t)16384 * PLE_K / 8, g0, gs);
        cvt_range(((const float*)(const GAS float*)a.in[3]) + (size_t)i * 32768 * PLE_K, (bf16*)(ws + WS_PB) + (size_t)i * M_TOK * PLE_K + (size_t)16384 * PLE_K, (size_t)32768 * PLE_K / 8, g0, gs);
    }
    cvt_range(((const float*)(const GAS float*)a.in[0]), (bf16*)(ws + WS_A2), (size_t)16384 * DM / 8, g0, gs);
    cvt_range(((const float*)(const GAS float*)a.in[1]), (bf16*)(ws + WS_A2) + (size_t)16384 * DM, (size_t)32768 * DM / 8, g0, gs);
    cvt_range_i8(((const float*)(const GAS float*)a.in[0]), ws + WS_A2Q, (size_t)16384 * DM / 8, g0, gs);
    cvt_range_i8(((const float*)(const GAS float*)a.in[1]), ws + WS_A2Q + (size_t)16384 * DM, (size_t)32768 * DM / 8, g0, gs);
    for (size_t e = g0; e < (size_t)SEQL * 16; e += gs) {
        const int pos = (int)(e >> 4), i = (int)(e & 15);
        const float ang = (float)pos * a.inv_freq[i];
        double s, c; sincos_d((double)ang, s, c);
        f32x2 o; o.x = (float)c; o.y = (float)s; ((f32x2*)(ws + WS_ROPE))[e] = o;
    }
}

__device__ __forceinline__ void ln_rows(bf16* XB, unsigned char* XQ, float* SA, const float* gain, const float* bias, int lane, int gw, int NGW) {
    float gv[16], bv[16];
#pragma unroll
    for (int q = 0; q < 4; ++q) { const f32x4 g4v = *(const f32x4*)(gain + (q >> 1) * 512 + 8 * lane + 4 * (q & 1)), b4v = *(const f32x4*)(bias + (q >> 1) * 512 + 8 * lane + 4 * (q & 1));
        gv[4 * q] = g4v.x; gv[4 * q + 1] = g4v.y; gv[4 * q + 2] = g4v.z; gv[4 * q + 3] = g4v.w; bv[4 * q] = b4v.x; bv[4 * q + 1] = b4v.y; bv[4 * q + 2] = b4v.z; bv[4 * q + 3] = b4v.w; }
    for (int r0 = gw; r0 < M_TOK; r0 += 2 * NGW) {
        v4u w[2][2];
#pragma unroll
        for (int j = 0; j < 2; ++j) { const int r = (r0 + j * NGW < M_TOK) ? r0 + j * NGW : r0; w[j][0] = *((const v4u*)(XB + (size_t)r * DM) + lane); w[j][1] = *((const v4u*)(XB + (size_t)r * DM + 512) + lane); }
#pragma unroll
        for (int j = 0; j < 2; ++j) { const int r = r0 + j * NGW; if (r < M_TOK) {
            float v[16]; float s = 0.f;
#pragma unroll
            for (int q = 0; q < 2; ++q) { const v4u x = w[j][q]; v[8 * q] = bflo(x.x); v[8 * q + 1] = bfhi(x.x); v[8 * q + 2] = bflo(x.y); v[8 * q + 3] = bfhi(x.y); v[8 * q + 4] = bflo(x.z); v[8 * q + 5] = bfhi(x.z); v[8 * q + 6] = bflo(x.w); v[8 * q + 7] = bfhi(x.w); }
#pragma unroll
            for (int e = 0; e < 16; ++e) s += v[e];
            const float mean = wave_sum(s) * (1.f / DM); float s2 = 0.f;
#pragma unroll
            for (int e = 0; e < 16; ++e) { v[e] -= mean; s2 += v[e] * v[e]; }
            const float rstd = 1.f / sqrtf(wave_sum(s2) * (1.f / DM) + LN_EPS);
#pragma unroll
            for (int e = 0; e < 16; ++e) v[e] = v[e] * rstd * gv[e] + bv[e];
#pragma unroll
            for (int q = 0; q < 2; ++q) { v4u o; o.x = pk2(v[8 * q], v[8 * q + 1]); o.y = pk2(v[8 * q + 2], v[8 * q + 3]); o.z = pk2(v[8 * q + 4], v[8 * q + 5]); o.w = pk2(v[8 * q + 6], v[8 * q + 7]); *((v4u*)(XB + (size_t)r * DM + 512 * q) + lane) = o; }
            float qi; const float sc = row_scale_i8(v, qi);
#pragma unroll
            for (int q = 0; q < 2; ++q) { v2u w; w.x = pack4_i8(v[8 * q], v[8 * q + 1], v[8 * q + 2], v[8 * q + 3], qi); w.y = pack4_i8(v[8 * q + 4], v[8 * q + 5], v[8 * q + 6], v[8 * q + 7], qi); *(v2u*)(XQ + (size_t)r * DM + 512 * q + 8 * lane) = w; }
            if (lane == 0) SA[r] = sc; } }
    }
}

__device__ __forceinline__ void attn_simple(const bf16* QKVp, bf16* Og, float* lse, int lane, int gw, int NGW) {
    const int NT = CH_SEQ * 3 * 8 * SEQL;
    const int per = (NT + NGW - 1) / NGW;
    const int t0 = gw * per, t1 = (t0 + per < NT) ? (t0 + per) : NT;
    for (int task = t0; task < t1; ++task) {
        const int tok = task & (SEQL - 1); const int pl = task >> 11; const int h = pl & 7; const int g = (pl >> 3) % 3; const int sq = pl / 24;
        const int sh = 2 * g, dil = 1 << sh, L = SEQL >> sh, r = tok & (dil - 1), p = tok >> sh;
        const bf16* Qp = QKVp + ((size_t)(((sq * 3 + g) * 3 + 0) * 8 + h) * SEQL) * 128;
        const bf16* Kp = QKVp + ((size_t)(((sq * 3 + g) * 3 + 1) * 8 + h) * SEQL) * 128;
        const bf16* Vp = QKVp + ((size_t)(((sq * 3 + g) * 3 + 2) * 8 + h) * SEQL) * 128;
        const v4u* qrow = (const v4u*)(Qp + (size_t)tok * 128);
        float sv[3];
#pragma unroll
        for (int e = 0; e < 3; ++e) {
            const int jj = lane + 64 * e; const int pp = p - 64 + jj; const bool ok = (jj <= 128) && (pp >= 0) && (pp < L);
            float s = -1e30f;
            if (ok) { const v4u* krow = (const v4u*)(Kp + (size_t)(r + dil * pp) * 128); float acc = 0.f;
#pragma unroll
                for (int c = 0; c < 16; ++c) { const v4u qv = qrow[c], kv = krow[c]; acc = dot2bf(qv.x, kv.x, acc); acc = dot2bf(qv.y, kv.y, acc); acc = dot2bf(qv.z, kv.z, acc); acc = dot2bf(qv.w, kv.w, acc); }
                s = acc; }
            sv[e] = s;
        }
        const float mx = wave_max(fmaxf(fmaxf(sv[0], sv[1]), sv[2]));
        float pv[3];
#pragma unroll
        for (int e = 0; e < 3; ++e) pv[e] = (sv[e] > -1e29f) ? exp2f(sv[e] - mx) : 0.f;
        const float den = wave_sum(pv[0] + pv[1] + pv[2]);
        float o0 = 0.f, o1 = 0.f;
        for (int jj = 0; jj <= 128; ++jj) {
            const float pj = __shfl(jj < 64 ? pv[0] : (jj < 128 ? pv[1] : pv[2]), jj & 63);
            if (pj != 0.f) { const int pp = p - 64 + jj; const unsigned vw = *((const unsigned*)(Vp + (size_t)(r + dil * pp) * 128) + lane); o0 += pj * bflo(vw); o1 += pj * bfhi(vw); }
        }
        const float inv = 1.f / den; const int row = sq * SEQL + tok;
        *((unsigned*)(Og + ((size_t)g * CH_ROWS + row) * DM + h * 128) + lane) = pk2(o0 * inv, o1 * inv);
        if (lane == 0) lse[((size_t)g * CH_ROWS + row) * 8 + h] = mx + log2f(den);
    }
}
typedef short s16x4 __attribute__((ext_vector_type(4)));
template <int OFF> __device__ __forceinline__ s16x4 tr_read(unsigned a) { s16x4 r; asm volatile("ds_read_b64_tr_b16 %0, %1 offset:%2" : "=&v"(r) : "v"(a), "i"(OFF) : "memory"); return r; }
constexpr int AT_RS = 288, AT_KOFF = 0, AT_VOFF = 256 * AT_RS;
template <int KP> __device__ __forceinline__ void attn_pv_step(f32x4 (&oacc)[8], unsigned vbase, bf16x8 pf) {
    s16x4 lo[8], hi[8];
#define AT_RD(DT) lo[DT] = tr_read<(32 * KP) * AT_RS + 32 * DT>(vbase); if constexpr (KP < 4) hi[DT] = tr_read<(32 * KP + 16) * AT_RS + 32 * DT>(vbase); else hi[DT] = (s16x4){0, 0, 0, 0};
    AT_RD(0) AT_RD(1) AT_RD(2) AT_RD(3) AT_RD(4) AT_RD(5) AT_RD(6) AT_RD(7)
#undef AT_RD
    asm volatile("s_waitcnt lgkmcnt(0)" ::: "memory"); __builtin_amdgcn_sched_barrier(0);
#pragma unroll
    for (int dt = 0; dt < 8; ++dt) { const bf16x8 vf = (bf16x8){lo[dt][0], lo[dt][1], lo[dt][2], lo[dt][3], hi[dt][0], hi[dt][1], hi[dt][2], hi[dt][3]};
        oacc[dt] = __builtin_amdgcn_mfma_f32_16x16x32_bf16(vf, pf, oacc[dt], 0, 0, 0); }
}
struct AttnUnit { const bf16 *Qpl, *Kpl, *Vpl; int g, h, sq, r, s, sh, dil, L; };
__device__ __forceinline__ AttnUnit attn_decode(const bf16* QKVp, int u) {
    AttnUnit a; const int w16 = u & 15; a.h = (u >> 4) & 7; a.g = (u >> 7) % 3; a.sq = u / 384;
    a.sh = 2 * a.g; a.dil = 1 << a.sh; a.L = SEQL >> a.sh; a.s = w16 & ((16 >> a.sh) - 1); a.r = w16 >> (4 - a.sh);
    const size_t pl = (size_t)((a.sq * 3 + a.g) * 3) * 8;
    a.Qpl = QKVp + ((pl + a.h) * SEQL) * 128; a.Kpl = QKVp + ((pl + 8 + a.h) * SEQL) * 128; a.Vpl = QKVp + ((pl + 16 + a.h) * SEQL) * 128;
    return a;
}
__device__ __forceinline__ void attn_fast(const bf16* QKVp, bf16* Og, float* lse, LAS unsigned char* lds, int tid, int lane, int wave, int bid, int G) {
    const int fr = lane & 15, g4 = lane >> 4;
    const int NU = CH_SEQ * 3 * 8 * 16;
    const int u0 = bid, u1 = NU, ustep = G;
    v4u kreg[8], vreg[4]; bf16x8 qn[4];
    if (u0 < u1) { const AttnUnit a = attn_decode(QKVp, u0);
        { const int qtok0 = a.r + a.dil * (128 * a.s + 16 * wave + fr);
#pragma unroll
          for (int ks = 0; ks < 4; ++ks) qn[ks] = *(const bf16x8*)(a.Qpl + (size_t)qtok0 * 128 + ks * 32 + g4 * 8); }
#pragma unroll
        for (int i = 0; i < 8; ++i) { const int cidx = tid + 512 * i, row = cidx >> 4, ch = cidx & 15; const int pp = 128 * a.s - 64 + row; const bool ok = (pp >= 0) && (pp < a.L); const size_t off = (size_t)(a.r + a.dil * pp) * 128 + ch * 8;
            kreg[i] = ok ? *(const v4u*)(a.Kpl + off) : (v4u){0u, 0u, 0u, 0u}; }
#pragma unroll
        for (int i = 0; i < 4; ++i) { const int cidx = tid + 512 * i, row = cidx >> 3, ch = cidx & 7; const int pp = 128 * a.s - 64 + row; const bool ok = (pp >= 0) && (pp < a.L);
            vreg[i] = ok ? *(const v4u*)((const unsigned char*)a.Vpl + (size_t)(a.r + a.dil * pp) * 128 + ch * 16) : (v4u){0u, 0u, 0u, 0u}; } }
    for (int u = u0; u < u1; u += ustep) {
        const AttnUnit a = attn_decode(QKVp, u);
        __syncthreads();
#pragma unroll
        for (int i = 0; i < 8; ++i) { const int cidx = tid + 512 * i, row = cidx >> 4, ch = cidx & 15;
            *(LAS v4u*)(lds + AT_KOFF + row * AT_RS + ch * 16) = kreg[i]; }
#pragma unroll
        for (int i = 0; i < 4; ++i) { const int cidx = tid + 512 * i, row = cidx >> 3, ch = cidx & 7; const v4u f8 = vreg[i]; v4u lo, hi;
#define F8BF(wd, ws) ({ const f32x2 t_ = __builtin_amdgcn_cvt_pk_f32_fp8((int)(wd), ws); pk2(t_[0], t_[1]); })
            lo.x = F8BF(f8.x, false); lo.y = F8BF(f8.x, true); lo.z = F8BF(f8.y, false); lo.w = F8BF(f8.y, true); hi.x = F8BF(f8.z, false); hi.y = F8BF(f8.z, true); hi.z = F8BF(f8.w, false); hi.w = F8BF(f8.w, true);
#undef F8BF
            *(LAS v4u*)(lds + AT_VOFF + row * AT_RS + ch * 32) = lo; *(LAS v4u*)(lds + AT_VOFF + row * AT_RS + ch * 32 + 16) = hi; }
        const int qtok = a.r + a.dil * (128 * a.s + 16 * wave + fr);
        bf16x8 qf[4];
#pragma unroll
        for (int ks = 0; ks < 4; ++ks) qf[ks] = qn[ks];
        __syncthreads();
        if (u + ustep < u1) { const AttnUnit b = attn_decode(QKVp, u + ustep);
            { const int qtokn = b.r + b.dil * (128 * b.s + 16 * wave + fr);
#pragma unroll
              for (int ks = 0; ks < 4; ++ks) qn[ks] = *(const bf16x8*)(b.Qpl + (size_t)qtokn * 128 + ks * 32 + g4 * 8); }
#pragma unroll
            for (int i = 0; i < 8; ++i) { const int cidx = tid + 512 * i, row = cidx >> 4, ch = cidx & 15; const int pp = 128 * b.s - 64 + row; const bool ok = (pp >= 0) && (pp < b.L); const size_t off = (size_t)(b.r + b.dil * pp) * 128 + ch * 8;
                kreg[i] = ok ? *(const v4u*)(b.Kpl + off) : (v4u){0u, 0u, 0u, 0u}; }
#pragma unroll
            for (int i = 0; i < 4; ++i) { const int cidx = tid + 512 * i, row = cidx >> 3, ch = cidx & 7; const int pp = 128 * b.s - 64 + row; const bool ok = (pp >= 0) && (pp < b.L);
                vreg[i] = ok ? *(const v4u*)((const unsigned char*)b.Vpl + (size_t)(b.r + b.dil * pp) * 128 + ch * 16) : (v4u){0u, 0u, 0u, 0u}; } }
        f32x4 sacc[9];
#pragma unroll
        for (int t = 0; t < 9; ++t) { f32x4 acc = {0.f, 0.f, 0.f, 0.f};
#pragma unroll
            for (int ks = 0; ks < 4; ++ks) { const bf16x8 kf = *(const LAS bf16x8*)(lds + AT_KOFF + (16 * (wave + t) + fr) * AT_RS + ks * 64 + g4 * 16);
                acc = __builtin_amdgcn_mfma_f32_16x16x32_bf16(kf, qf[ks], acc, 0, 0, 0); }
            sacc[t] = acc; }
        float mx = -1e30f;
#pragma unroll
        for (int t = 0; t < 9; ++t)
#pragma unroll
            for (int e = 0; e < 4; ++e) { const int dd = 16 * t + 4 * g4 + e - fr; const int pos = 128 * a.s - 64 + 16 * (wave + t) + 4 * g4 + e;
                const bool ok = (dd >= 0) && (dd <= 128) && (pos >= 0) && (pos < a.L); const float sv = ok ? sacc[t][e] : -1e30f; sacc[t][e] = sv; mx = fmaxf(mx, sv); }
        mx = fmaxf(mx, __shfl_xor(mx, 16)); mx = fmaxf(mx, __shfl_xor(mx, 32));
        float den = 0.f;
#pragma unroll
        for (int t = 0; t < 9; ++t)
#pragma unroll
            for (int e = 0; e < 4; ++e) { const float pv = (sacc[t][e] > -1e29f) ? __builtin_amdgcn_exp2f(sacc[t][e] - mx) : 0.f; sacc[t][e] = pv; den += pv; }
        den += __shfl_xor(den, 16); den += __shfl_xor(den, 32);
        bf16x8 pf[5];
#pragma unroll
        for (int kp = 0; kp < 5; ++kp) { v4u w; w.x = pk2(sacc[2 * kp][0], sacc[2 * kp][1]); w.y = pk2(sacc[2 * kp][2], sacc[2 * kp][3]);
            if (kp < 4) { w.z = pk2(sacc[2 * kp + 1][0], sacc[2 * kp + 1][1]); w.w = pk2(sacc[2 * kp + 1][2], sacc[2 * kp + 1][3]); } else { w.z = 0u; w.w = 0u; }
            pf[kp] = __builtin_bit_cast(bf16x8, w); }
        f32x4 oacc[8];
#pragma unroll
        for (int dt = 0; dt < 8; ++dt) oacc[dt] = (f32x4){0.f, 0.f, 0.f, 0.f};
        const unsigned vbase = (unsigned)(uintptr_t)(lds + AT_VOFF) + (unsigned)((16 * wave + 4 * g4 + ((lane & 15) >> 2)) * AT_RS + 8 * (lane & 3));
        attn_pv_step<0>(oacc, vbase, pf[0]); attn_pv_step<1>(oacc, vbase, pf[1]); attn_pv_step<2>(oacc, vbase, pf[2]); attn_pv_step<3>(oacc, vbase, pf[3]); attn_pv_step<4>(oacc, vbase, pf[4]);
        const float inv = 1.f / den; const size_t orow = (size_t)a.g * CH_ROWS + (size_t)a.sq * SEQL + qtok;
        bf16* op = Og + orow * DM + a.h * 128 + 4 * g4;
#pragma unroll
        for (int dt = 0; dt < 8; ++dt) { v2u w; w.x = pk2(oacc[dt][0] * inv, oacc[dt][1] * inv); w.y = pk2(oacc[dt][2] * inv, oacc[dt][3] * inv); *(v2u*)(op + 16 * dt) = w; }
        if (g4 == 0) lse[orow * 8 + a.h] = mx + log2f(den);
    }
}
__device__ __forceinline__ void combine_rows(const bf16* Og, const float* lse, unsigned char* OQ, float* SA, int lane, int gw, int NGW) {
    const int h = lane >> 3;
    for (int row0 = gw; row0 < CH_ROWS; row0 += 2 * NGW) {
        v4u x0[2][2], x1[2][2], x2[2][2]; float l0[2], l1[2], l2[2];
#pragma unroll
        for (int j = 0; j < 2; ++j) { const int row = (row0 + j * NGW < CH_ROWS) ? row0 + j * NGW : row0;
            l0[j] = lse[((size_t)0 * CH_ROWS + row) * 8 + h]; l1[j] = lse[((size_t)1 * CH_ROWS + row) * 8 + h]; l2[j] = lse[((size_t)2 * CH_ROWS + row) * 8 + h];
#pragma unroll
            for (int q = 0; q < 2; ++q) { x0[j][q] = *((const v4u*)(Og + ((size_t)0 * CH_ROWS + row) * DM) + 2 * lane + q); x1[j][q] = *((const v4u*)(Og + ((size_t)1 * CH_ROWS + row) * DM) + 2 * lane + q); x2[j][q] = *((const v4u*)(Og + ((size_t)2 * CH_ROWS + row) * DM) + 2 * lane + q); } }
#pragma unroll
        for (int j = 0; j < 2; ++j) { const int row = row0 + j * NGW; if (row < CH_ROWS) {
            const float mx = fmaxf(fmaxf(l0[j], l1[j]), l2[j]); float w0 = exp2f(l0[j] - mx), w1 = exp2f(l1[j] - mx), w2 = exp2f(l2[j] - mx); const float inv = 1.f / (w0 + w1 + w2); w0 *= inv; w1 *= inv; w2 *= inv;
            float r[16];
#pragma unroll
            for (int q = 0; q < 2; ++q) { const v4u a = x0[j][q], b = x1[j][q], c = x2[j][q];
#define CMB(cc, e) r[8 * q + e] = w0 * bflo(a.cc) + w1 * bflo(b.cc) + w2 * bflo(c.cc); r[8 * q + e + 1] = w0 * bfhi(a.cc) + w1 * bfhi(b.cc) + w2 * bfhi(c.cc);
                CMB(x, 0) CMB(y, 2) CMB(z, 4) CMB(w, 6)
#undef CMB
            }
            float qi; const float sc = row_scale_i8(r, qi);
            v4u w; w.x = pack4_i8(r[0], r[1], r[2], r[3], qi); w.y = pack4_i8(r[4], r[5], r[6], r[7], qi); w.z = pack4_i8(r[8], r[9], r[10], r[11], qi); w.w = pack4_i8(r[12], r[13], r[14], r[15], qi);
            *((v4u*)(OQ + (size_t)row * DM) + lane) = w;
            if (lane == 0) SA[row] = sc; } }
    }
}
__device__ __forceinline__ void conv_rows(const bf16* H, const bf16* GB, const float* ck, unsigned char* YQ, float* SA, int lane, int gw, int NGW) {
    float k0[16], k1[16], k2[16];
#pragma unroll
    for (int q = 0; q < 2; ++q)
#pragma unroll
        for (int e = 0; e < 2; ++e) { const int c0 = 512 * q + 8 * lane; const f32x4 a = *(const f32x4*)(ck + c0 + 4 * e), b = *(const f32x4*)(ck + DM + c0 + 4 * e), c = *(const f32x4*)(ck + 2 * DM + c0 + 4 * e);
            const int o = 8 * q + 4 * e; k0[o] = a.x; k0[o + 1] = a.y; k0[o + 2] = a.z; k0[o + 3] = a.w; k1[o] = b.x; k1[o + 1] = b.y; k1[o + 2] = b.z; k1[o + 3] = b.w; k2[o] = c.x; k2[o + 1] = c.y; k2[o + 2] = c.z; k2[o + 3] = c.w; }
    for (int row0 = gw; row0 < M_TOK; row0 += 2 * NGW) {
        v4u hm[2][2], hc[2][2], hn[2][2], gb[2][2];
#pragma unroll
        for (int j = 0; j < 2; ++j) { const int row = (row0 + j * NGW < M_TOK) ? row0 + j * NGW : row0; const int t = row & (SEQL - 1);
#pragma unroll
            for (int q = 0; q < 2; ++q) { const int c0 = 512 * q + 8 * lane;
                hm[j][q] = (t > 0) ? *(const v4u*)(H + (size_t)(row - 1) * DM + c0) : (v4u){0u, 0u, 0u, 0u};
                hc[j][q] = *(const v4u*)(H + (size_t)row * DM + c0);
                hn[j][q] = (t < SEQL - 1) ? *(const v4u*)(H + (size_t)(row + 1) * DM + c0) : (v4u){0u, 0u, 0u, 0u};
                gb[j][q] = *(const v4u*)(GB + (size_t)row * DM + c0); } }
#pragma unroll
        for (int j = 0; j < 2; ++j) { const int row = row0 + j * NGW; if (row < M_TOK) {
            float r[16];
#pragma unroll
            for (int q = 0; q < 2; ++q) { const v4u m_ = hm[j][q], c_ = hc[j][q], n_ = hn[j][q], g_ = gb[j][q];
#define CV(c, e) r[8 * q + e] = bflo(g_.c) * (k0[8 * q + e] * bflo(m_.c) + k1[8 * q + e] * bflo(c_.c) + k2[8 * q + e] * bflo(n_.c)); r[8 * q + e + 1] = bfhi(g_.c) * (k0[8 * q + e + 1] * bfhi(m_.c) + k1[8 * q + e + 1] * bfhi(c_.c) + k2[8 * q + e + 1] * bfhi(n_.c));
                CV(x, 0) CV(y, 2) CV(z, 4) CV(w, 6)
#undef CV
            }
            float qi; const float sc = row_scale_i8(r, qi);
#pragma unroll
            for (int q = 0; q < 2; ++q) { v2u w; w.x = pack4_i8(r[8 * q], r[8 * q + 1], r[8 * q + 2], r[8 * q + 3], qi); w.y = pack4_i8(r[8 * q + 4], r[8 * q + 5], r[8 * q + 6], r[8 * q + 7], qi);
                *(v2u*)(YQ + (size_t)row * DM + 512 * q + 8 * lane) = w; }
            if (lane == 0) SA[row] = sc; } }
    }
}
__device__ __forceinline__ void argmax_step(float& bv, int& bi) {
#pragma unroll
    for (int o = 1; o < 64; o <<= 1) { const float ov = __shfl_xor(bv, o); const int oi = __shfl_xor(bi, o); const bool take = (ov > bv) || (ov == bv && oi < bi); bv = take ? ov : bv; bi = take ? oi : bi; }
}
__device__ __forceinline__ void select_simple(const bf16* Qp, const bf16* SK, v2u* SEL, int lane, int gw, int NGW) {
    const int NT = M_TOK * 8;
    const int per = (NT + NGW - 1) / NGW;
    const int t0 = gw * per, t1 = (t0 + per < NT) ? (t0 + per) : NT;
    for (int task = t0; task < t1; ++task) {
        const int tok = task >> 3, h = task & 7;
        float topv[2]; int topi[2];
#pragma unroll
        for (int p = 0; p < 2; ++p) {
            const v4u* qrow = (const v4u*)(Qp + (size_t)tok * PQ_N + h * 256 + p * 128);
            const v4u* k0 = (const v4u*)(SK + ((size_t)(h * 2 + p) * 128 + lane) * 128);
            const v4u* k1 = (const v4u*)(SK + ((size_t)(h * 2 + p) * 128 + lane + 64) * 128);
            float s0 = 0.f, s1 = 0.f;
#pragma unroll
            for (int c = 0; c < 16; ++c) { const v4u qv = qrow[c], a = k0[c], b = k1[c];
                s0 = dot2bf(qv.x, a.x, s0); s0 = dot2bf(qv.y, a.y, s0); s0 = dot2bf(qv.z, a.z, s0); s0 = dot2bf(qv.w, a.w, s0);
                s1 = dot2bf(qv.x, b.x, s1); s1 = dot2bf(qv.y, b.y, s1); s1 = dot2bf(qv.z, b.z, s1); s1 = dot2bf(qv.w, b.w, s1); }
            float myv = -3e38f; int myi = 0;
            for (int k = 0; k < 16; ++k) {
                float bv = (s0 >= s1) ? s0 : s1; int bi = (s0 >= s1) ? lane : lane + 64;
                argmax_step(bv, bi);
                if (lane == k) { myv = bv; myi = bi; }
                if (bi == lane) s0 = -3e38f;
                if (bi == lane + 64) s1 = -3e38f;
            }
            topv[p] = myv; topi[p] = myi;
        }
        float cv[4];
        const float av = __shfl(topv[0], lane >> 2);
#pragma unroll
        for (int e = 0; e < 4; ++e) cv[e] = av + __shfl(topv[1], 4 * (lane & 3) + e);
        float fv = -3e38f; int fc = 0;
        for (int k = 0; k < 16; ++k) {
            float bv = cv[0]; int bi = 4 * lane;
#pragma unroll
            for (int e = 1; e < 4; ++e) if (cv[e] > bv) { bv = cv[e]; bi = 4 * lane + e; }
            argmax_step(bv, bi);
            if (lane == k) { fv = bv; fc = bi; }
#pragma unroll
            for (int e = 0; e < 4; ++e) if (bi == 4 * lane + e) cv[e] = -3e38f;
        }
        const int ea = __shfl(topi[0], (fc >> 4) & 15), eb = __shfl(topi[1], fc & 15);
        const float fmax_ = __shfl(fv, 0);
        const float ex = (lane < 16) ? __expf(fv - fmax_) : 0.f;
        const float sum = wave_sum(ex);
        if (lane < 16) { v2u o; o.x = (unsigned)(ea * 128 + eb); o.y = __builtin_bit_cast(unsigned, ex / sum); SEL[((size_t)tok * 8 + h) * 16 + lane] = o; }
    }
}
__device__ __forceinline__ int fkey(float f) { const int b = __builtin_bit_cast(int, f); return b ^ ((b >> 31) & 0x7fffffff); }
__device__ __forceinline__ float fkey_inv(int k) { const int b = k ^ ((k >> 31) & 0x7fffffff); return __builtin_bit_cast(float, b); }
__device__ __forceinline__ void list_insert(int (&L)[16], int x) {
#pragma unroll
    for (int i = 0; i < 16; ++i) { const int hi = max(L[i], x); x = min(L[i], x); L[i] = hi; }
}
#define CE_(a, b) do { t_ = max((a), (b)); (b) = min((a), (b)); (a) = t_; } while (0)
#define SORT16_DESC(K) do { int t_; \
 CE_(K[0], K[1]); CE_(K[2], K[3]); CE_(K[0], K[2]); CE_(K[1], K[3]); CE_(K[1], K[2]); CE_(K[4], K[5]); CE_(K[6], K[7]); CE_(K[4], K[6]); CE_(K[5], K[7]); \
 CE_(K[5], K[6]); CE_(K[0], K[4]); CE_(K[2], K[6]); CE_(K[2], K[4]); CE_(K[1], K[5]); CE_(K[3], K[7]); CE_(K[3], K[5]); CE_(K[1], K[2]); CE_(K[3], K[4]); \
 CE_(K[5], K[6]); CE_(K[8], K[9]); CE_(K[10], K[11]); CE_(K[8], K[10]); CE_(K[9], K[11]); CE_(K[9], K[10]); CE_(K[12], K[13]); CE_(K[14], K[15]); CE_(K[12], K[14]); \
 CE_(K[13], K[15]); CE_(K[13], K[14]); CE_(K[8], K[12]); CE_(K[10], K[14]); CE_(K[10], K[12]); CE_(K[9], K[13]); CE_(K[11], K[15]); CE_(K[11], K[13]); CE_(K[9], K[10]); \
 CE_(K[11], K[12]); CE_(K[13], K[14]); CE_(K[0], K[8]); CE_(K[4], K[12]); CE_(K[4], K[8]); CE_(K[2], K[10]); CE_(K[6], K[14]); CE_(K[6], K[10]); CE_(K[2], K[4]); \
 CE_(K[6], K[8]); CE_(K[10], K[12]); CE_(K[1], K[9]); CE_(K[5], K[13]); CE_(K[5], K[9]); CE_(K[3], K[11]); CE_(K[7], K[15]); CE_(K[7], K[11]); CE_(K[3], K[5]); \
 CE_(K[7], K[9]); CE_(K[11], K[13]); CE_(K[1], K[2]); CE_(K[3], K[4]); CE_(K[5], K[6]); CE_(K[7], K[8]); CE_(K[9], K[10]); CE_(K[11], K[12]); CE_(K[13], K[14]); \
 } while (0)
#define MERGE16_DESC(L, K) do { int t_; _Pragma("unroll") for (int i_ = 0; i_ < 16; ++i_) L[i_] = max(L[i_], K[15 - i_]); \
    _Pragma("unroll") for (int s_ = 8; s_ >= 1; s_ >>= 1) { _Pragma("unroll") for (int i_ = 0; i_ < 16; ++i_) if ((i_ & s_) == 0) CE_(L[i_], L[i_ + s_]); } } while (0)
constexpr float SL_BIAS = 96.0f;
constexpr int SL_RS = 272, SL_WAVE = 64 * SL_RS;
__device__ __forceinline__ void select_fast(const bf16* Qp_, const bf16* SK, v2u* SEL_, LAS unsigned char* lds, int lane, int wave, int u0, int u1, int du) {
    const int fr = lane & 15, g4 = lane >> 4, h = wave;
    LAS unsigned char* scr = lds + wave * SL_WAVE;
    for (int u = u0; u < u1; u += du) {
        const int tok0 = u * 64;
        int LA[16], LB[16];
#pragma unroll
        for (int i = 0; i < 16; ++i) { LA[i] = (int)0x80000000; LB[i] = (int)0x80000000; }
#pragma unroll
        for (int p = 0; p < 2; ++p) {
            bf16x8 qf[4][4];
#pragma unroll
            for (int tt = 0; tt < 4; ++tt)
#pragma unroll
                for (int ks = 0; ks < 4; ++ks) qf[tt][ks] = *(const bf16x8*)(Qp_ + (size_t)(tok0 + 16 * tt + fr) * PQ_N + h * 256 + p * 128 + ks * 32 + g4 * 8);
#pragma unroll 1
            for (int kh = 0; kh < 2; ++kh) {
                bf16x8 kf[4][4];
#pragma unroll
                for (int kt = 0; kt < 4; ++kt)
#pragma unroll
                    for (int ks = 0; ks < 4; ++ks) kf[kt][ks] = *(const bf16x8*)(SK + ((size_t)(h * 2 + p) * 128 + 64 * kh + 16 * kt + fr) * 128 + ks * 32 + g4 * 8);
#pragma unroll
                for (int kt = 0; kt < 4; ++kt)
#pragma unroll
                    for (int tt = 0; tt < 4; ++tt) { f32x4 acc = {0.f, 0.f, 0.f, 0.f};
#pragma unroll
                        for (int ks = 0; ks < 4; ++ks) acc = __builtin_amdgcn_mfma_f32_16x16x32_bf16(kf[kt][ks], qf[tt][ks], acc, 0, 0, 0);
                        *(LAS f32x4*)(scr + (16 * tt + fr) * SL_RS + (16 * kt + 4 * g4) * 4) = acc; }
                asm volatile("s_waitcnt lgkmcnt(0)" ::: "memory");
#pragma unroll
                for (int c4 = 0; c4 < 4; ++c4) { int K[16];
#pragma unroll
                    for (int q = 0; q < 4; ++q) { const f32x4 v = *(const LAS f32x4*)(scr + lane * SL_RS + (4 * c4 + q) * 16); const int ib = 64 * kh + 16 * c4 + 4 * q;
                        K[4 * q] = (__builtin_bit_cast(int, v.x + SL_BIAS) & ~127) | ib; K[4 * q + 1] = (__builtin_bit_cast(int, v.y + SL_BIAS) & ~127) | (ib + 1); K[4 * q + 2] = (__builtin_bit_cast(int, v.z + SL_BIAS) & ~127) | (ib + 2); K[4 * q + 3] = (__builtin_bit_cast(int, v.w + SL_BIAS) & ~127) | (ib + 3); }
                    SORT16_DESC(K);
                    if (p == 0) { MERGE16_DESC(LA, K); } else { MERGE16_DESC(LB, K); } }
                asm volatile("s_waitcnt lgkmcnt(0)" ::: "memory");
            }
        }
        float af[16], bfv[16];
#pragma unroll
        for (int i = 0; i < 16; ++i) { af[i] = __builtin_bit_cast(float, LA[i] & ~127); bfv[i] = __builtin_bit_cast(float, LB[i] & ~127);
            *(LAS int*)(scr + lane * SL_RS + 4 * i) = LA[i] & 127; *(LAS int*)(scr + lane * SL_RS + 64 + 4 * i) = LB[i] & 127; }
#define PAIRKEY(i, j) ((__builtin_bit_cast(int, af[i] + bfv[j]) & ~255) | ((15 - (i)) << 4) | (15 - (j)))
        int F[16];
#pragma unroll
        for (int j = 0; j < 16; ++j) F[j] = PAIRKEY(0, j);
        { int K[16] = {PAIRKEY(1, 0), PAIRKEY(1, 1), PAIRKEY(1, 2), PAIRKEY(1, 3), PAIRKEY(1, 4), PAIRKEY(1, 5), PAIRKEY(1, 6), PAIRKEY(1, 7), PAIRKEY(2, 0), PAIRKEY(2, 1), PAIRKEY(2, 2), PAIRKEY(2, 3), PAIRKEY(2, 4), PAIRKEY(3, 0), PAIRKEY(3, 1), PAIRKEY(3, 2)};
          SORT16_DESC(K); MERGE16_DESC(F, K); }
        { int K[16] = {PAIRKEY(3, 3), PAIRKEY(4, 0), PAIRKEY(4, 1), PAIRKEY(4, 2), PAIRKEY(5, 0), PAIRKEY(5, 1), PAIRKEY(6, 0), PAIRKEY(6, 1), PAIRKEY(7, 0), PAIRKEY(7, 1), PAIRKEY(8, 0), PAIRKEY(9, 0), PAIRKEY(10, 0), PAIRKEY(11, 0), PAIRKEY(12, 0), PAIRKEY(13, 0)};
          SORT16_DESC(K); MERGE16_DESC(F, K); }
        list_insert(F, PAIRKEY(14, 0)); list_insert(F, PAIRKEY(15, 0));
#undef PAIRKEY
        asm volatile("s_waitcnt lgkmcnt(0)" ::: "memory");
        float ev[16]; unsigned ex[16]; float sum = 0.f; const float f0 = __builtin_bit_cast(float, F[0] & ~255);
#pragma unroll
        for (int k = 0; k < 16; ++k) { const int code = F[k] & 255; const int ia = *(const LAS int*)(scr + lane * SL_RS + 4 * (15 - (code >> 4))); const int ib = *(const LAS int*)(scr + lane * SL_RS + 64 + 4 * (15 - (code & 15)));
            ex[k] = (unsigned)(ia * 128 + ib); ev[k] = __expf(__builtin_bit_cast(float, F[k] & ~255) - f0);     sum += ev[k]; }
        const float inv = 1.f / sum;
        { v4u* o = (v4u*)(SEL_ + ((size_t)(tok0 + lane) * 8 + h) * 16);
#pragma unroll
            for (int k = 0; k < 8; ++k) { v4u w; w.x = ex[2 * k]; w.y = __builtin_bit_cast(unsigned, ev[2 * k] * inv); w.z = ex[2 * k + 1]; w.w = __builtin_bit_cast(unsigned, ev[2 * k + 1] * inv); o[k] = w; } }
        asm volatile("s_waitcnt lgkmcnt(0)" ::: "memory");
    }
}
__device__ __forceinline__ float gelu_erf(float v) {
    const float t = __builtin_amdgcn_rcpf(fabsf(v) * 0.2316418882f + 1.0f);
    float q = t * 0.5307027145f + (-0.7265760135f); q = q * t + 0.7107068705f; q = q * t + (-0.142248368f); q = q * t + 0.127414796f; q = q * t;
    const float m = v * (q * __builtin_amdgcn_exp2f((v * v) * (-0.72134752044f)));
    return v < 0.f ? m : v - m;
}
__device__ __forceinline__ void gather_rows(float* X, bf16* XB, const v2u* SEL, const bf16* U, const bf16* V, const float* gain, const float* bias, int lane, int gw, int NGW) {
    for (int tok = gw; tok < M_TOK; tok += NGW) {
        const v2u sa = SEL[(size_t)tok * 128 + lane], sb = SEL[(size_t)tok * 128 + 64 + lane];
        const v4u x0 = *((const v4u*)(XB + (size_t)tok * DM) + lane), x1 = *((const v4u*)(XB + (size_t)tok * DM + 512) + lane);
        float f[16];
#pragma unroll
        for (int e = 0; e < 16; ++e) f[e] = 0.f;
        for (int b = 0; b < 32; ++b) {
            v4u u0[4], u1[4], w0[4], w1[4];
#pragma unroll
            for (int e = 0; e < 4; ++e) {
                const int k = 4 * b + e;
                const unsigned eid = (unsigned)__builtin_amdgcn_readlane((int)(k < 64 ? sa.x : sb.x), k & 63);
                const v4u* ur = (const v4u*)(U + (size_t)eid * DM); const v4u* vr = (const v4u*)(V + (size_t)eid * DM);
                u0[e] = ur[lane]; u1[e] = ur[64 + lane]; w0[e] = vr[lane]; w1[e] = vr[64 + lane];
            }
#pragma unroll
            for (int e = 0; e < 4; ++e) {
                const int k = 4 * b + e;
                float d = 0.f;
                d = dot2bf(u0[e].x, x0.x, d); d = dot2bf(u0[e].y, x0.y, d); d = dot2bf(u0[e].z, x0.z, d); d = dot2bf(u0[e].w, x0.w, d);
                d = dot2bf(u1[e].x, x1.x, d); d = dot2bf(u1[e].y, x1.y, d); d = dot2bf(u1[e].z, x1.z, d); d = dot2bf(u1[e].w, x1.w, d);
                d = wave_sum(d);
                const float gk = __builtin_bit_cast(float, (unsigned)__builtin_amdgcn_readlane((int)(k < 64 ? sa.y : sb.y), k & 63));
                const float c = gk * gelu_erf(d);
                f[0] += c * bflo(w0[e].x); f[1] += c * bfhi(w0[e].x); f[2] += c * bflo(w0[e].y); f[3] += c * bfhi(w0[e].y);
                f[4] += c * bflo(w0[e].z); f[5] += c * bfhi(w0[e].z); f[6] += c * bflo(w0[e].w); f[7] += c * bfhi(w0[e].w);
                f[8] += c * bflo(w1[e].x); f[9] += c * bfhi(w1[e].x); f[10] += c * bflo(w1[e].y); f[11] += c * bfhi(w1[e].y);
                f[12] += c * bflo(w1[e].z); f[13] += c * bfhi(w1[e].z); f[14] += c * bflo(w1[e].w); f[15] += c * bfhi(w1[e].w);
            }
        }
        float* xr = X + (size_t)tok * DM;
        float z[16];
#pragma unroll
        for (int q = 0; q < 4; ++q) { const f32x4 xv = *(const f32x4*)(xr + (q >> 1) * 512 + 8 * lane + 4 * (q & 1)); z[4 * q] = DN_ALPHA * xv.x + f[4 * q]; z[4 * q + 1] = DN_ALPHA * xv.y + f[4 * q + 1]; z[4 * q + 2] = DN_ALPHA * xv.z + f[4 * q + 2]; z[4 * q + 3] = DN_ALPHA * xv.w + f[4 * q + 3]; }
        float s = 0.f;
#pragma unroll
        for (int e = 0; e < 16; ++e) s += z[e];
        const float mean = wave_sum(s) * (1.f / DM); float s2 = 0.f;
#pragma unroll
        for (int e = 0; e < 16; ++e) { z[e] -= mean; s2 += z[e] * z[e]; }
        const float rstd = 1.f / sqrtf(wave_sum(s2) * (1.f / DM) + LN_EPS);
#pragma unroll
        for (int q = 0; q < 4; ++q) { const int c = (q >> 1) * 512 + 8 * lane + 4 * (q & 1); const f32x4 gv = *(const f32x4*)(gain + c), bv = *(const f32x4*)(bias + c);
            f32x4 o; o.x = z[4 * q] * rstd * gv.x + bv.x; o.y = z[4 * q + 1] * rstd * gv.y + bv.y; o.z = z[4 * q + 2] * rstd * gv.z + bv.z; o.w = z[4 * q + 3] * rstd * gv.w + bv.w;
            *(f32x4*)(xr + c) = o; v2u w; w.x = pk2(o.x, o.y); w.y = pk2(o.z, o.w); *(v2u*)(XB + (size_t)tok * DM + c) = w; }
    }
}

#define G8_ISSUE(UU, VV, B) do { const int b_ = (B); _Pragma("unroll") for (int e = 0; e < 8; ++e) { const int k_ = 8 * b_ + e; \
        const unsigned eid_ = (unsigned)__builtin_amdgcn_readlane((int)(b_ < 8 ? sa.x : sb.x), k_ & 63); \
        UU[e] = *((const v4u*)(U8 + (size_t)eid_ * DM) + lane); VV[e] = *((const v4u*)(V8 + (size_t)eid_ * DM) + lane); } } while (0)
#define G8_COMPUTE(UU, VV, B) do { const int b_ = (B); float d_[8]; \
        _Pragma("unroll") for (int e = 0; e < 8; ++e) { f32x2 acc_ = {0.f, 0.f}; \
            _Pragma("unroll") for (int w = 0; w < 4; ++w) { acc_ = __builtin_elementwise_fma(__builtin_amdgcn_cvt_pk_f32_fp8((int)UU[e][w], false), x[2 * w], acc_); acc_ = __builtin_elementwise_fma(__builtin_amdgcn_cvt_pk_f32_fp8((int)UU[e][w], true), x[2 * w + 1], acc_); } \
            d_[e] = acc_.x + acc_.y; } \
        float r_[4], q_[2], t_; \
        _Pragma("unroll") for (int i = 0; i < 4; ++i) { const float snd = h32 ? d_[i] : d_[i + 4], kp = h32 ? d_[i + 4] : d_[i]; r_[i] = kp + __shfl_xor(snd, 32); } \
        _Pragma("unroll") for (int i = 0; i < 2; ++i) { const float snd = h16 ? r_[i] : r_[i + 2], kp = h16 ? r_[i + 2] : r_[i]; q_[i] = kp + __shfl_xor(snd, 16); } \
        { const float snd = h8 ? q_[0] : q_[1], kp = h8 ? q_[1] : q_[0]; t_ = kp + __shfl_xor(snd, 8); } \
        t_ += __shfl_xor(t_, 4); t_ += __shfl_xor(t_, 2); t_ += __shfl_xor(t_, 1); \
        const int src_ = (8 * b_ + el) & 63; \
        const float gv_ = __builtin_bit_cast(float, __shfl((int)(b_ < 8 ? sa.y : sb.y), src_)), us_ = __builtin_bit_cast(float, __shfl((int)(b_ < 8 ? sa.z : sb.z), src_)); \
        const float cf_ = gv_ * gelu_erf(t_ * us_); \
        _Pragma("unroll") for (int e = 0; e < 8; ++e) { const float c_ = __builtin_bit_cast(float, __builtin_amdgcn_readlane(__builtin_bit_cast(int, cf_), 8 * e)); const f32x2 c2_ = {c_, c_}; \
            _Pragma("unroll") for (int w = 0; w < 4; ++w) { f[2 * w] = __builtin_elementwise_fma(__builtin_amdgcn_cvt_pk_f32_fp8((int)VV[e][w], false), c2_, f[2 * w]); f[2 * w + 1] = __builtin_elementwise_fma(__builtin_amdgcn_cvt_pk_f32_fp8((int)VV[e][w], true), c2_, f[2 * w + 1]); } } \
    } while (0)
__device__ __forceinline__ void gather_fp8(float* X, float* Xo, bf16* XB, const v4u* SEL_, const unsigned char* U8, const unsigned char* V8, const float* gain, const float* bias, int lane, int gw, int NGW) {
    const bool h32 = (lane & 32) != 0, h16 = (lane & 16) != 0, h8 = (lane & 8) != 0; const int el = (lane >> 3) & 7;
    for (int tok = gw; tok < M_TOK; tok += NGW) {
        const v4u sa = SEL_[(size_t)tok * 128 + lane], sb = SEL_[(size_t)tok * 128 + 64 + lane];
        float* xr = X + (size_t)tok * DM + 16 * lane;
        f32x2 x[8], f[8];
#pragma unroll
        for (int q = 0; q < 4; ++q) { const f32x4 xv = *((const f32x4*)xr + q); x[2 * q] = (f32x2){xv.x, xv.y}; x[2 * q + 1] = (f32x2){xv.z, xv.w}; f[2 * q] = (f32x2){0.f, 0.f}; f[2 * q + 1] = (f32x2){0.f, 0.f}; }
        v4u ua[8], va[8], ub[8], vb[8];
        G8_ISSUE(ua, va, 0);
#pragma unroll 1
        for (int bb = 0; bb < 8; ++bb) {
            G8_ISSUE(ub, vb, 2 * bb + 1);
            G8_COMPUTE(ua, va, 2 * bb);
            if (bb < 7) G8_ISSUE(ua, va, 2 * bb + 2);
            G8_COMPUTE(ub, vb, 2 * bb + 1);
        }
        float z[16];
#pragma unroll
        for (int q = 0; q < 8; ++q) { z[2 * q] = DN_ALPHA * x[q].x + f[q].x; z[2 * q + 1] = DN_ALPHA * x[q].y + f[q].y; }
        float s = 0.f;
#pragma unroll
        for (int e = 0; e < 16; ++e) s += z[e];
        const float mean = wave_sum(s) * (1.f / DM); float s2 = 0.f;
#pragma unroll
        for (int e = 0; e < 16; ++e) { z[e] -= mean; s2 += z[e] * z[e]; }
        const float rstd = 1.f / sqrtf(wave_sum(s2) * (1.f / DM) + LN_EPS);
        unsigned pw[8];
#pragma unroll
        for (int q = 0; q < 4; ++q) { const f32x4 gv = *((const f32x4*)(gain + 16 * lane) + q), bv = *((const f32x4*)(bias + 16 * lane) + q);
            f32x4 o; o.x = z[4 * q] * rstd * gv.x + bv.x; o.y = z[4 * q + 1] * rstd * gv.y + bv.y; o.z = z[4 * q + 2] * rstd * gv.z + bv.z; o.w = z[4 * q + 3] * rstd * gv.w + bv.w;
            *((f32x4*)(Xo + (size_t)tok * DM + 16 * lane) + q) = o; pw[2 * q] = pk2(o.x, o.y); pw[2 * q + 1] = pk2(o.z, o.w); }
        v4u* ob = (v4u*)(XB + (size_t)tok * DM + 16 * lane);
        ob[0] = (v4u){pw[0], pw[1], pw[2], pw[3]}; ob[1] = (v4u){pw[4], pw[5], pw[6], pw[7]};
    }
}
__device__ __forceinline__ float ub0(unsigned w) { float r; asm("v_cvt_f32_ubyte0 %0, %1" : "=v"(r) : "v"(w)); return r; }
__device__ __forceinline__ float ub1(unsigned w) { float r; asm("v_cvt_f32_ubyte1 %0, %1" : "=v"(r) : "v"(w)); return r; }
__device__ __forceinline__ float ub2(unsigned w) { float r; asm("v_cvt_f32_ubyte2 %0, %1" : "=v"(r) : "v"(w)); return r; }
__device__ __forceinline__ float ub3(unsigned w) { float r; asm("v_cvt_f32_ubyte3 %0, %1" : "=v"(r) : "v"(w)); return r; }
#define G4_ISSUE(DD, SS, B) do { const int b_ = (B); _Pragma("unroll") for (int e = 0; e < 4; ++e) { const int k_ = 4 * b_ + e; \
        const unsigned ro_ = (unsigned)__builtin_amdgcn_readlane((int)(b_ < 16 ? sa.x : sb.x), k_ & 63) * (unsigned)T4_ROW; \
        DD[e] = *(const v4u*)(T4 + (size_t)(ro_ + lane16)); SS[e] = *(const unsigned short*)(T4 + (size_t)(ro_ + 1024u + lane2x)); } } while (0)
#define G4_ISSUE_M(DD, SS, B, M) do { const int b_ = (B); _Pragma("unroll") for (int e = 0; e < 4; ++e) { const int k_ = 4 * b_ + e; \
        const unsigned ro_ = (unsigned)__builtin_amdgcn_readlane((int)(b_ < 16 ? sa.x : sb.x), k_ & 63) * (M); \
        DD[e] = *(const v4u*)(T4 + (size_t)(ro_ + lane16)); SS[e] = *(const unsigned short*)(T4 + (size_t)(ro_ + 1024u + lane2x)); } } while (0)
#define G4_COMPUTE(DD, SS, B) do { const int b_ = (B); float d_[4]; \
        _Pragma("unroll") for (int e = 0; e < 4; ++e) { const unsigned w0_ = DD[e].x, w1_ = DD[e].y; int di_ = 0; \
            di_ = __builtin_amdgcn_sdot4((int)(w0_ & 0x0F0F0F0Fu), xq[0], di_, false); di_ = __builtin_amdgcn_sdot4((int)((w0_ >> 4) & 0x0F0F0F0Fu), xq[1], di_, false); \
            di_ = __builtin_amdgcn_sdot4((int)(w1_ & 0x0F0F0F0Fu), xq[2], di_, false); di_ = __builtin_amdgcn_sdot4((int)((w1_ >> 4) & 0x0F0F0F0Fu), xq[3], di_, false); \
            d_[e] = __builtin_amdgcn_cvt_pk_f32_fp8((int)SS[e], false)[0] * ((float)di_ * sxl - xoffs); } \
        float q_[2], t_; \
          \
          \
        _Pragma("unroll") for (int i = 0; i < 2; ++i) { float a_ = d_[i], b_ = d_[i + 2]; asm volatile("s_nop 1\n\tv_permlane32_swap_b32 %0, %1" : "+v"(a_), "+v"(b_)); q_[i] = a_ + b_; } \
        { float a_ = q_[0], b_ = q_[1]; asm volatile("s_nop 1\n\tv_permlane16_swap_b32 %0, %1" : "+v"(a_), "+v"(b_)); t_ = a_ + b_; }     \
        t_ += __builtin_bit_cast(float, __builtin_amdgcn_update_dpp(0, __builtin_bit_cast(int, t_), 0x128, 0xf, 0xf, false));     \
        t_ += __builtin_bit_cast(float, __builtin_amdgcn_update_dpp(0, __builtin_bit_cast(int, t_), 0x124, 0xf, 0xf, false));     \
        t_ += __builtin_bit_cast(float, __builtin_amdgcn_update_dpp(0, __builtin_bit_cast(int, t_), 0x122, 0xf, 0xf, false));     \
        t_ += __builtin_bit_cast(float, __builtin_amdgcn_update_dpp(0, __builtin_bit_cast(int, t_), 0x121, 0xf, 0xf, false));     \
        const float gv_ = __builtin_bit_cast(float, __shfl((int)(b_ < 16 ? sa.y : sb.y), (4 * b_ + el) & 63)); \
        const float cf_ = gv_ * (1.0f / 1024.0f) * gelu_erf(t_); \
        _Pragma("unroll") for (int e = 0; e < 4; ++e) { const float c_ = __builtin_bit_cast(float, __builtin_amdgcn_readlane(__builtin_bit_cast(int, cf_), 16 * e)); \
            const float cs_ = c_ * __builtin_amdgcn_cvt_pk_f32_fp8((int)SS[e], false)[1]; const f32x2 cs2_ = {cs_, cs_}; \
            f2[0] = __builtin_elementwise_fma((f32x2)__builtin_amdgcn_cvt_scalef32_pk_f32_fp4(DD[e].z, 1.0f, 0), cs2_, f2[0]); f2[1] = __builtin_elementwise_fma((f32x2)__builtin_amdgcn_cvt_scalef32_pk_f32_fp4(DD[e].z, 1.0f, 1), cs2_, f2[1]); \
            f2[2] = __builtin_elementwise_fma((f32x2)__builtin_amdgcn_cvt_scalef32_pk_f32_fp4(DD[e].z, 1.0f, 2), cs2_, f2[2]); f2[3] = __builtin_elementwise_fma((f32x2)__builtin_amdgcn_cvt_scalef32_pk_f32_fp4(DD[e].z, 1.0f, 3), cs2_, f2[3]); \
            f2[4] = __builtin_elementwise_fma((f32x2)__builtin_amdgcn_cvt_scalef32_pk_f32_fp4(DD[e].w, 1.0f, 0), cs2_, f2[4]); f2[5] = __builtin_elementwise_fma((f32x2)__builtin_amdgcn_cvt_scalef32_pk_f32_fp4(DD[e].w, 1.0f, 1), cs2_, f2[5]); \
            f2[6] = __builtin_elementwise_fma((f32x2)__builtin_amdgcn_cvt_scalef32_pk_f32_fp4(DD[e].w, 1.0f, 2), cs2_, f2[6]); f2[7] = __builtin_elementwise_fma((f32x2)__builtin_amdgcn_cvt_scalef32_pk_f32_fp4(DD[e].w, 1.0f, 3), cs2_, f2[7]); } \
    } while (0)
__device__ __forceinline__ void sel_bucket_sort(v2u& sa, v2u& sb, int lane, LAS unsigned char* wl) {
    const unsigned ba = sa.x >> 11, bb = sb.x >> 11;
    const unsigned long long lt = (1ull << lane) - 1ull;
    unsigned base = 0u, da = 0u, db = 0u;
#pragma unroll
    for (unsigned k = 0; k < 8; ++k) {
        const unsigned long long ma = __ballot(ba == k), mb = __ballot(bb == k);
        const unsigned ca = (unsigned)__popcll(ma), cb = (unsigned)__popcll(mb);
        da = (ba == k) ? base + (unsigned)__popcll(ma & lt) : da;
        db = (bb == k) ? base + ca + (unsigned)__popcll(mb & lt) : db;
        base += ca + cb;
    }
    *(LAS v2u*)(wl + 8u * da) = sa; *(LAS v2u*)(wl + 8u * db) = sb;
    asm volatile("s_waitcnt lgkmcnt(0)" ::: "memory");
    sa = *(const LAS v2u*)(wl + 8 * lane); sb = *(const LAS v2u*)(wl + 8 * (64 + lane));
    asm volatile("s_waitcnt lgkmcnt(0)" ::: "memory");
}
__device__ __forceinline__ void gather_i4(const bf16* XI, bf16* XB, unsigned char* XQ, float* SA, const v2u* SEL_, const unsigned char* T4, const float* gain, const float* bias, LAS unsigned char* wl, int lane, int t0, int t1, int dt) {
    const bool h32 = (lane & 32) != 0, h16 = (lane & 16) != 0; const int el = (lane >> 4) & 3; const unsigned lane16 = 16u * lane, lane2x = 2u * lane;
    v4u d0[4], d1[4], d2[4], d3[4], d4[4]; unsigned short sc0[4], sc1[4], sc2[4], sc3[4], sc4[4];
    v2u sa = {0u, 0u}, sb = {0u, 0u};
    v4u xn[2] = {{0u, 0u, 0u, 0u}, {0u, 0u, 0u, 0u}};
    if (t0 < t1) { sa = SEL_[(size_t)t0 * 128 + lane]; sb = SEL_[(size_t)t0 * 128 + 64 + lane]; xn[0] = *((const v4u*)(XI + (size_t)t0 * DM + 16 * lane)); xn[1] = *((const v4u*)(XI + (size_t)t0 * DM + 16 * lane) + 1); sel_bucket_sort(sa, sb, lane, wl); G4_ISSUE(d0, sc0, 0); G4_ISSUE(d1, sc1, 1); G4_ISSUE(d2, sc2, 2); G4_ISSUE(d3, sc3, 3); }
    for (int tok = t0; tok < t1; tok += dt) {
        const bool has_next = tok + dt < t1;
        f32x2 f2[8]; float sxl, xoffs; int xq[4];
        {
            float x[16];
#pragma unroll
            for (int q = 0; q < 2; ++q) { const v4u xv = xn[q]; x[8 * q] = bflo(xv.x); x[8 * q + 1] = bfhi(xv.x); x[8 * q + 2] = bflo(xv.y); x[8 * q + 3] = bfhi(xv.y); x[8 * q + 4] = bflo(xv.z); x[8 * q + 5] = bfhi(xv.z); x[8 * q + 6] = bflo(xv.w); x[8 * q + 7] = bfhi(xv.w); }
            float ax = 0.f;
#pragma unroll
            for (int e = 0; e < 16; ++e) { ax = fmaxf(ax, fabsf(x[e])); f2[e >> 1] = (f32x2){0.f, 0.f}; }
            sxl = (ax > 0.f) ? ax * (1.0f / 127.0f) : 1.0f; const float isx = 1.0f / sxl;
            int msum = 0;
#pragma unroll
            for (int w = 0; w < 4; ++w) { int pk = 0;
#pragma unroll
                for (int j = 0; j < 4; ++j) { const int idx = 8 * (w >> 1) + 2 * j + (w & 1); const int m = (int)rintf(x[idx] * isx); msum += m; pk |= (m & 0xff) << (8 * j); }
                xq[w] = pk; }
            xoffs = 7.5f * (float)msum * sxl * (1.0f / 1024.0f); sxl *= (1.0f / 1024.0f);
            asm volatile("" : "+v"(xq[0]), "+v"(xq[1]), "+v"(xq[2]), "+v"(xq[3]), "+v"(sxl), "+v"(xoffs));
        }
#pragma unroll 1
        for (int bb = 0; bb < 6; ++bb) {
            G4_ISSUE(d4, sc4, 5 * bb + 4);  G4_COMPUTE(d0, sc0, 5 * bb);
            G4_ISSUE(d0, sc0, 5 * bb + 5);  G4_COMPUTE(d1, sc1, 5 * bb + 1);
            G4_ISSUE(d1, sc1, 5 * bb + 6);  G4_COMPUTE(d2, sc2, 5 * bb + 2);
            if (bb < 5) G4_ISSUE(d2, sc2, 5 * bb + 7);  G4_COMPUTE(d3, sc3, 5 * bb + 3);
            if (bb < 5) G4_ISSUE(d3, sc3, 5 * bb + 8);  G4_COMPUTE(d4, sc4, 5 * bb + 4);
        }
        const int tokn = has_next ? tok + dt : tok;
        const v2u na = SEL_[(size_t)tokn * 128 + lane], nb = SEL_[(size_t)tokn * 128 + 64 + lane];
        G4_COMPUTE(d0, sc0, 30); G4_COMPUTE(d1, sc1, 31);
        int lane2 = lane; asm volatile("" : "+v"(lane2));
        const size_t eoff = (size_t)tok * DM + 16 * lane2;
        v4u xv2[2]; f32x4 gvv[4], bvv[4];
#pragma unroll
        for (int q = 0; q < 2; ++q) xv2[q] = *((const v4u*)(XI + eoff) + q);
#pragma unroll
        for (int q = 0; q < 4; ++q) { gvv[q] = *((const f32x4*)(gain + 16 * lane2) + q); bvv[q] = *((const f32x4*)(bias + 16 * lane2) + q); }
        xn[0] = *((const v4u*)(XI + (size_t)tokn * DM + 16 * lane2)); xn[1] = *((const v4u*)(XI + (size_t)tokn * DM + 16 * lane2) + 1);
        asm volatile("" ::: "memory");
        sa = na; sb = nb; sel_bucket_sort(sa, sb, lane, wl);
        { const unsigned rm_ = has_next ? (unsigned)T4_ROW : 0u;
          G4_ISSUE_M(d0, sc0, 0, rm_); G4_ISSUE_M(d1, sc1, 1, rm_); G4_ISSUE_M(d2, sc2, 2, rm_); G4_ISSUE_M(d3, sc3, 3, rm_); }
        asm volatile("" ::: "memory");
        float z[16]; float s = 0.f;
#pragma unroll
        for (int q = 0; q < 2; ++q) { const v4u xv = xv2[q];
            z[8 * q] = DN_ALPHA * bflo(xv.x) + f2[4 * q].x; z[8 * q + 1] = DN_ALPHA * bfhi(xv.x) + f2[4 * q].y; z[8 * q + 2] = DN_ALPHA * bflo(xv.y) + f2[4 * q + 1].x; z[8 * q + 3] = DN_ALPHA * bfhi(xv.y) + f2[4 * q + 1].y;
            z[8 * q + 4] = DN_ALPHA * bflo(xv.z) + f2[4 * q + 2].x; z[8 * q + 5] = DN_ALPHA * bfhi(xv.z) + f2[4 * q + 2].y; z[8 * q + 6] = DN_ALPHA * bflo(xv.w) + f2[4 * q + 3].x; z[8 * q + 7] = DN_ALPHA * bfhi(xv.w) + f2[4 * q + 3].y; }
#pragma unroll
        for (int e = 0; e < 16; ++e) s += z[e];
        const float mean = wave_sum(s) * (1.f / DM); float s2 = 0.f;
#pragma unroll
        for (int e = 0; e < 16; ++e) { z[e] -= mean; s2 += z[e] * z[e]; }
        const float rstd = 1.f / sqrtf(wave_sum(s2) * (1.f / DM) + LN_EPS);
        unsigned pw[8];
#pragma unroll
        for (int q = 0; q < 4; ++q) { const f32x4 gv = gvv[q], bv = bvv[q];
            z[4 * q] = z[4 * q] * rstd * gv.x + bv.x; z[4 * q + 1] = z[4 * q + 1] * rstd * gv.y + bv.y; z[4 * q + 2] = z[4 * q + 2] * rstd * gv.z + bv.z; z[4 * q + 3] = z[4 * q + 3] * rstd * gv.w + bv.w;
            pw[2 * q] = pk2(z[4 * q], z[4 * q + 1]); pw[2 * q + 1] = pk2(z[4 * q + 2], z[4 * q + 3]); }
        v4u* ob = (v4u*)(XB + eoff);
        ob[0] = (v4u){pw[0], pw[1], pw[2], pw[3]}; ob[1] = (v4u){pw[4], pw[5], pw[6], pw[7]};
        {
            float qi; const float sc = row_scale_i8(z, qi);
            v4u w; w.x = pack4_i8(z[0], z[1], z[2], z[3], qi); w.y = pack4_i8(z[4], z[5], z[6], z[7], qi); w.z = pack4_i8(z[8], z[9], z[10], z[11], qi); w.w = pack4_i8(z[12], z[13], z[14], z[15], qi);
            *(v4u*)(XQ + (size_t)tok * DM + 16 * lane2) = w;
            if (lane2 == 0) SA[tok] = sc;
        }
    }
}
__global__ void __launch_bounds__(NTHR, 2) mk_fwd(Args args) {
    extern __shared__ __attribute__((aligned(16))) unsigned char lds_raw[];
    LAS unsigned char* lds = (LAS unsigned char*)lds_raw;
    const int tid0_ = threadIdx.x, wave = __builtin_amdgcn_readfirstlane(tid0_ >> 6);
    const int G = gridDim.x, bid = blockIdx.x;
    const int gw = bid * NWAVES + wave, NGW = G * NWAVES;
    unsigned char* ws0_ = args.ws; float* X0_ = args.out;
    const int lo = args.ph_lo, hi = args.ph_hi;
    volatile LAS unsigned* MISC = (volatile LAS unsigned*)(lds + MISC_OFF);
    if (tid0_ < 128) MISC[tid0_] = 0u;
    __syncthreads();
    XcdBarrier bar; bar.bar = (unsigned*)(ws0_ + WS_CTL) + CW_BAR; bar.x = 0; bar.st = MISC;
    if (hi - lo > 1) bar = xcd_barrier_post((unsigned*)(ws0_ + WS_CTL) + CW_BAR, MISC);
    int ph = 0;
#define PH_BEGIN if (ph >= lo && ph < hi) { for (int prep_ = 0; prep_ < ((ph == PROBE_PH) ? 2 : 1); ++prep_) { int tid = tid0_; asm volatile("" : "+v"(tid)); const int lane = tid & 63; GAS unsigned char* wsg_ = (GAS unsigned char*)ws0_; asm volatile("" : "+s"(wsg_)); unsigned char* ws = (unsigned char*)wsg_; GAS float* Xg_ = (GAS float*)X0_; asm volatile("" : "+s"(Xg_)); float* X = (float*)Xg_; \
        bf16* A1 = (bf16*)(ws + WS_A1); bf16* A2 = (bf16*)(ws + WS_A2); bf16* A3 = (bf16*)(ws + WS_A3); unsigned char* A3Q = ws + WS_A3Q; unsigned char* A2Q = ws + WS_A2Q; (void)A2Q; unsigned char* A1Q = ws + WS_A1Q; float* SA1 = (float*)(ws + WS_SA1); float* SA3 = (float*)(ws + WS_SA3); (void)A1; (void)A2; (void)A3; (void)A3Q; (void)A1Q; (void)SA1; (void)SA3; (void)X; (void)lane; (void)tid;
#define PH_END   if (ph + 1 < hi) xcd_barrier(bar); } } ++ph;
#define GIN(k) ((const float*)(const GAS float*)args.in[k])
#define QKVp ((bf16*)(ws + WS_R1))
#define Og ((bf16*)(ws + WS_R2 + R2_OG))
#define lse ((float*)(ws + WS_R2 + R2_LSE))
#define Hc ((bf16*)(ws + WS_R1 + R1_H))
#define GBc ((bf16*)(ws + WS_R1 + R1_GB))
#define Qp ((bf16*)(ws + WS_R1 + R1_QP))
#define PP ((bf16*)(ws + WS_R1 + R1_PP))
#define SEL ((v2u*)(ws + WS_R2 + R2_SEL))

    PH_BEGIN for (int rep_ = 0; rep_ < 1 + PROBE_P; ++rep_) { prologue(args, ws, lds, tid, lane, wave, bid, G); __syncthreads(); } PH_END

    for (int i = 0; i < 4; ++i) {
        const int j = i >> 1;
        if ((i & 1) == 0) {
            for (int c = 0; c < NCHUNK; ++c) {
                PH_BEGIN {
                    pg8::Gemm g{(const bf16*)(A2Q + (size_t)c * CH_ROWS * DM), (const bf16*)(ws + WS_WQKV + (size_t)j * QKV_N * 1024), CH_ROWS, QKV_N, 512};
                    pg8::StaticOrder S; S.init(CH_ROWS, QKV_N, G, bid);
                    EpiQKV E{QKVp, (const f32x2*)(ws + WS_ROPE), (const float*)(ws + WS_WSQKV) + j * QKV_N};
#if PROBE_N
                    { EpiNull En; pg8::gemm_phase<EpiNull, pg8::StaticOrder, false>(lds, g, S, En, nullptr); __syncthreads(); }
#endif
                    for (int rep_ = 0; rep_ < 1 + PROBE_M; ++rep_) { pg8::gemm_phase<EpiQKV, pg8::StaticOrder, false, true>(lds, g, S, E, nullptr); __syncthreads(); }
                    if (c > 0) combine_rows(Og, lse, A3Q + (size_t)(c - 1) * CH_ROWS * DM, SA3 + (size_t)(c - 1) * CH_ROWS, lane, gw, NGW);
                } PH_END
                PH_BEGIN for (int rep_ = 0; rep_ < 1 + PROBE_A; ++rep_) { attn_fast(QKVp, Og, lse, lds, tid, lane, wave, bid, G); __syncthreads(); } PH_END
            }
            PH_BEGIN combine_rows(Og, lse, A3Q + (size_t)(NCHUNK - 1) * CH_ROWS * DM, SA3 + (size_t)(NCHUNK - 1) * CH_ROWS, lane, gw, NGW); PH_END
        } else {
            PH_BEGIN {
                pg8::Gemm g{(const bf16*)A2Q, (const bf16*)(ws + WS_WCIN + (size_t)j * 3072 * 1024), M_TOK, 3072, 512};
                pg8::StaticOrder S; S.init(M_TOK, 3072, G, bid);
                EpiCin E{Hc, GBc, (const float*)(ws + WS_WSCIN) + j * 3072};
                for (int rep_ = 0; rep_ < 1 + PROBE_M; ++rep_) { pg8::gemm_phase<EpiCin, pg8::StaticOrder, false, true>(lds, g, S, E, nullptr); __syncthreads(); }
            } PH_END
            PH_BEGIN for (int rep_ = 0; rep_ < 1 + PROBE_L; ++rep_) conv_rows(Hc, GBc, GIN(7) + (size_t)j * 3 * DM, A3Q, SA3, lane, gw, NGW); PH_END
        }
        PH_BEGIN {
            const unsigned char* Wt = (i & 1) ? ws + WS_WCOUT + (size_t)j * 1024 * 1024 : ws + WS_WO + (size_t)j * 1024 * 1024;
            pg8::Gemm g{(const bf16*)A3Q, (const bf16*)Wt, M_TOK, DM, 512};
            pg8::StaticOrder S; S.init(M_TOK, DM, G, bid);
            EpiResid E{A2, A1, SA3, (const float*)(ws + WS_WSC) + ((i & 1) ? 2 + j : j) * 1024};
            pg8::gemm_phase<EpiResid, pg8::StaticOrder, false, true>(lds, g, S, E, nullptr);
        } PH_END
        PH_BEGIN ln_rows(A1, A1Q, SA1, GIN(13) + (size_t)i * DM, GIN(14) + (size_t)i * DM, lane, gw, NGW); PH_END
        PH_BEGIN {
            {
                pg8::Gemm g{(const bf16*)A1Q, (const bf16*)(ws + WS_WPQ + (size_t)i * PQ_N * 1024), M_TOK, PQ_N, 512};
                pg8::StaticOrder S; S.init(M_TOK, PQ_N, G, bid);
                EpiQp E{Qp, SA1, (const float*)(ws + WS_WSPQ) + i * PQ_N};
                for (int rep_ = 0; rep_ < 1 + PROBE_M; ++rep_) { pg8::gemm_phase<EpiQp, pg8::StaticOrder, false, true>(lds, g, S, E, nullptr); __syncthreads(); }
            }
            __syncthreads();
            {
                pg8::Gemm g{(const bf16*)(ws + WS_PB) + (size_t)i * M_TOK * PLE_K, (const bf16*)(ws + WS_WPP) + (size_t)i * 1024 * PLE_K, M_TOK, DM, PLE_K};
                pg8::StaticOrder S; S.init(M_TOK, DM, G, bid);
                pg8::EpiBf16<0> E{PP, DM, nullptr, 0, 0};
                for (int rep_ = 0; rep_ < 1 + PROBE_M; ++rep_) { pg8::gemm_phase<pg8::EpiBf16<0>, pg8::StaticOrder, false>(lds, g, S, E, nullptr); __syncthreads(); }
            }
        } PH_END
        PH_BEGIN {
            const bf16* SKi = (const bf16*)(ws + WS_SK) + (size_t)i * 8 * 2 * 128 * 128; const unsigned char* T4i = ws + WS_U + (size_t)i * NEXP * T4_ROW;
            const int NU = M_TOK / 64, nu = (bid < NU) ? (NU - 1 - bid) / G + 1 : 0, pre = 1;
            int sdone = 0;
            for (int gdone = 0; gdone < nu; ++gdone) {
                while (sdone < nu && sdone < gdone + pre) {
                    const int u = bid + sdone * G; int t_ = tid0_; asm volatile("" : "+v"(t_)); select_fast(Qp, SKi, SEL, lds, t_ & 63, wave, u, u + 1, 1);
                    ++sdone; __syncthreads(); }
                { const int u = bid + gdone * G; int t_ = tid0_; asm volatile("" : "+v"(t_)); gather_i4(A1, A1, A1Q, SA1, SEL, T4i, GIN(15) + (size_t)i * DM, GIN(16) + (size_t)i * DM, lds + wave * SL_WAVE, t_ & 63, u * 64 + wave, u * 64 + 64, 8); }
            }
        } PH_END
        PH_BEGIN {
            pg8::Gemm g{(const bf16*)A1Q, (const bf16*)(ws + WS_WG + (size_t)i * 1024 * 1024), M_TOK, DM, 512};
            pg8::StaticOrder S; S.init(M_TOK, DM, G, bid);
            EpiGate E{A1, PP, A2, (i == 3) ? X : (float*)nullptr, SA1, (const float*)(ws + WS_WSC) + (4 + i) * 1024, A2Q};
            pg8::gemm_phase<EpiGate, pg8::StaticOrder, false, true>(lds, g, S, E, nullptr);
        } PH_END
    }
#undef PH_BEGIN
#undef GIN
#undef PH_END
#undef QKVp
#undef Og
#undef lse
#undef Hc
#undef GBc
#undef Qp
#undef PP
#undef SEL
}

extern "C" void kernel_launch(void* const* d_in, const int* in_sizes, int n_in, void* d_out, int out_size, void* d_ws, size_t ws_size, hipStream_t stream) {
    static int grid = 0;
    if (grid == 0) {
        if (n_in != 19 || out_size != M_TOK * DM || ws_size < WS_END) { fprintf(stderr, "kernel_launch: unexpected shapes (n_in %d out %d ws %zu)\n", n_in, out_size, ws_size); grid = -1; return; }
        int dev = 0, cus = 0, per_cu = 0;
        if (hipGetDevice(&dev) != hipSuccess || hipDeviceGetAttribute(&cus, hipDeviceAttributeMultiprocessorCount, dev) != hipSuccess) { grid = -1; return; }
        if (hipFuncSetAttribute((const void*)mk_fwd, hipFuncAttributeMaxDynamicSharedMemorySize, LDS_BYTES) != hipSuccess) { fprintf(stderr, "kernel_launch: hipFuncSetAttribute failed\n"); grid = -1; return; }
        if (hipOccupancyMaxActiveBlocksPerMultiprocessor(&per_cu, (const void*)mk_fwd, NTHR, LDS_BYTES) != hipSuccess || per_cu < 1) { fprintf(stderr, "kernel_launch: occupancy query says %d\n", per_cu); }
        (void)hipGetLastError();
        grid = cus;
    }
    if (grid < 0) return;
    (void)hipMemsetAsync((char*)d_ws + WS_CTL, 0, CTL_ZERO_BYTES, stream);
    Args a{};
    for (int i = 0; i < 19; ++i) a.in[i] = (const float*)d_in[i];
    a.out = (float*)d_out; a.ws = (unsigned char*)d_ws;
    static const float invf[16] = {1.0f, 0.44036659598350525f, 0.1939227432012558f, 0.08539710193872452f, 0.03760603070259094f, 0.01656043902039528f, 0.007292664609849453f, 0.0032114458736032248f,
                                   0.0014142135623842478f, 0.000622772378847003f, 0.00027424818836152554f, 0.00012076973507646471f, 5.318296098266728e-05f, 2.34199997066753e-05f, 1.0313386155758053e-05f, 4.541670477919979e-06f};
    for (int i = 0; i < 16; ++i) a.inv_freq[i] = invf[i];
#if ONE_LAUNCH
    a.ph_lo = 0; a.ph_hi = N_PHASES;
    hipLaunchKernelGGL(mk_fwd, dim3(grid), dim3(NTHR), LDS_BYTES, stream, a);
#else
    for (int p = 0; p < N_PHASES; ++p) { a.ph_lo = p; a.ph_hi = p + 1; hipLaunchKernelGGL(mk_fwd, dim3(grid), dim3(NTHR), LDS_BYTES, stream, a); }
#endif
}
```

```cpp
#include <hip/hip_runtime.h>
#include <stdint.h>
#include <stdio.h>
namespace pg8 {
#define PG8_LAS __attribute__((address_space(3)))
typedef unsigned short bf16_t;
typedef short bf16x8 __attribute__((ext_vector_type(8)));
typedef float f32x4 __attribute__((ext_vector_type(4)));
typedef unsigned u32x4 __attribute__((ext_vector_type(4)));
typedef int i32x4 __attribute__((ext_vector_type(4)));
constexpr int BM = 256, BK = 64, HALF = 128, HTB = HALF * BK * 2  , STAGE_BYTES = 8 * HTB, NXCD = 8, WGM = 8;

__host__ __device__ __forceinline__ int lds_byte(int r, int c) { const int st = (r >> 4) * 2 + (c >> 5), rr = r & 15, cc = c & 31, ob = rr * 64 + cc * 2; return st * 1024 + (ob ^ (((ob >> 9) & 1) << 5)); }
__host__ __device__ __forceinline__ void stage_rc(int b, int& R, int& C) { const int st = b / 1024, sb = b % 1024, swz = sb ^ (((sb >> 9) & 1) << 5); R = (st >> 1) * 16 + swz / 64; C = (st & 1) * 32 + (swz % 64) / 2; }
__host__ __device__ __forceinline__ int perm32(int rho) { const int n = rho >> 4, i = rho & 15; return 8 * (i >> 2) + 4 * n + (i & 3); }

struct Unit { int pm, pn; };
struct Gemm { const bf16_t* A; const bf16_t* Bt; int M, N, K; };

struct StaticOrder {
    int nM, nN, nwg, G, c;
    __host__ __device__ void init(int M, int N, int G_, int c_) { nM = M / BM; nN = N / BM; nwg = nM * nN; G = G_; c = c_; }
    __host__ __device__ bool next(int i, Unit& u) const {
        const long L = (long)i * G + c; if (L >= nwg) return false;
        int wgid = (int)L; { const int q = nwg / NXCD, r = nwg % NXCD, xcd = wgid % NXCD, off = wgid / NXCD; wgid = (xcd < r ? xcd * (q + 1) : r * (q + 1) + (xcd - r) * q) + off; }
        const int nig = WGM * nN, gid = wgid / nig, fm = gid * WGM, gsz = (nM - fm) < WGM ? (nM - fm) : WGM;
        u.pm = fm + ((wgid % nig) % gsz); u.pn = (wgid % nig) / gsz; return true;
    }
    __device__ __forceinline__ void a_ready(const Unit&) const {}
    __device__ __forceinline__ void done(const Unit&) const {}
};
struct CountedOrder : StaticOrder {
    const unsigned* ready; unsigned need; unsigned* tmo;
    __device__ __forceinline__ void a_ready(const Unit& u) const {
        if (threadIdx.x < 64) {
            const unsigned long long t0 = __builtin_amdgcn_s_memrealtime(); unsigned polls = 0;
            while ((unsigned)__builtin_amdgcn_readfirstlane(__hip_atomic_load(ready + 64 * u.pm, __ATOMIC_RELAXED, __HIP_MEMORY_SCOPE_AGENT)) < need) {
                if ((++polls & 255u) == 0u && __builtin_amdgcn_readfirstlane(__hip_atomic_load(tmo, __ATOMIC_RELAXED, __HIP_MEMORY_SCOPE_AGENT)) != 0u) break;
                if (__builtin_amdgcn_s_memrealtime() - t0 > 2000000ull) {
                    if (threadIdx.x == 0) { unsigned expect = 0u; __hip_atomic_compare_exchange_strong(tmo + 1, &expect, 0x600u | (unsigned)(u.pm & 0xff), __ATOMIC_RELAXED, __ATOMIC_RELAXED, __HIP_MEMORY_SCOPE_AGENT); __hip_atomic_store(tmo, 1u, __ATOMIC_RELAXED, __HIP_MEMORY_SCOPE_AGENT); }
                    break; }
                __builtin_amdgcn_s_sleep(2); }
            __builtin_amdgcn_fence(__ATOMIC_ACQUIRE, "agent");
            asm volatile("s_waitcnt vmcnt(0)" ::: "memory");
        }
#if !defined(BROKEN_HOOK_NO_BARRIER)
        asm volatile("" ::: "memory"); __builtin_amdgcn_s_barrier(); asm volatile("" ::: "memory");
#endif
    }
};

__device__ __forceinline__ unsigned cvt_pk_bf16(float lo, float hi) { unsigned r; asm volatile("v_cvt_pk_bf16_f32 %0, %1, %2" : "=v"(r) : "v"(lo), "v"(hi)); return r; }
typedef float f32x2 __attribute__((ext_vector_type(2)));
__device__ __forceinline__ f32x2 gelu_pk(f32x2 v) {
    const f32x2 av = __builtin_elementwise_abs(v), d = av * 0.2316418882f + 1.0f;
    f32x2 t; t.x = __builtin_amdgcn_rcpf(d.x); t.y = __builtin_amdgcn_rcpf(d.y);
    f32x2 q = t * 0.5307027145f + (-0.7265760135f); q = q * t + 0.7107068705f; q = q * t + (-0.142248368f); q = q * t + 0.127414796f; q = q * t;
    const f32x2 s = (v * v) * (-0.72134752044f);
    f32x2 e; e.x = __builtin_amdgcn_exp2f(s.x); e.y = __builtin_amdgcn_exp2f(s.y);
    const f32x2 m = v * (q * e), r = v - m;
    f32x2 o; o.x = v.x < 0.f ? m.x : r.x; o.y = v.y < 0.f ? m.y : r.y; return o;
}

struct EpiF32 {
    static constexpr bool PERM = false, AFTER_DRAIN = false;
    float* C; int ldc; const float* bias;
    __device__ __forceinline__ void operator()(const f32x4 (&acc)[2][2][4][2], const Unit& u, int wr, int wc, int fr, int fq) const {
        const int row0 = u.pm * BM + wr * 64 + fr, col0 = u.pn * BM + wc * 32 + 4 * fq;
        f32x4 bv[2][2];
#pragma unroll
        for (int bj = 0; bj < 2; ++bj)
#pragma unroll
            for (int n = 0; n < 2; ++n) bv[bj][n] = bias ? *(const f32x4*)(bias + col0 + bj * HALF + n * 16) : (f32x4){0.f, 0.f, 0.f, 0.f};
#pragma unroll
        for (int ai = 0; ai < 2; ++ai)
#pragma unroll
            for (int m = 0; m < 4; ++m) { float* rowp = C + (size_t)(row0 + ai * HALF + m * 16) * ldc + col0;
#pragma unroll
                for (int bj = 0; bj < 2; ++bj)
#pragma unroll
                    for (int n = 0; n < 2; ++n) *(f32x4*)(rowp + bj * HALF + n * 16) = acc[ai][bj][m][n] + bv[bj][n]; }
    }
};
template <int ACT  > struct EpiBf16 {
    static constexpr bool PERM = true, AFTER_DRAIN = false;
    bf16_t* O; int ldc; const float* bias; int split_cols; size_t split_stride;
    __device__ __forceinline__ void operator()(const f32x4 (&acc)[2][2][4][2], const Unit& u, int wr, int wc, int fr, int fq) const {
        const int row0 = u.pm * BM + wr * 64 + fr; int colt = u.pn * BM; bf16_t* base = O;
        if (split_cols) { const int t = colt / split_cols; base += (size_t)t * split_stride; colt -= t * split_cols; }
        const int col0 = colt + wc * 32 + 8 * fq, bcol0 = u.pn * BM + wc * 32 + 8 * fq;
        f32x4 bv[2][2];
#pragma unroll
        for (int bj = 0; bj < 2; ++bj)
#pragma unroll
            for (int n = 0; n < 2; ++n) bv[bj][n] = bias ? *(const f32x4*)(bias + bcol0 + bj * HALF + 4 * n) : (f32x4){0.f, 0.f, 0.f, 0.f};
#pragma unroll
        for (int ai = 0; ai < 2; ++ai)
#pragma unroll
            for (int m = 0; m < 4; ++m) { bf16_t* rowp = base + (size_t)(row0 + ai * HALF + m * 16) * ldc + col0;
#pragma unroll
                for (int bj = 0; bj < 2; ++bj) { f32x4 v0 = acc[ai][bj][m][0] + bv[bj][0], v1 = acc[ai][bj][m][1] + bv[bj][1];
                    if (ACT == 1) { f32x2 a = gelu_pk((f32x2){v0[0], v0[1]}), b = gelu_pk((f32x2){v0[2], v0[3]}), c = gelu_pk((f32x2){v1[0], v1[1]}), d = gelu_pk((f32x2){v1[2], v1[3]});
                        v0 = (f32x4){a.x, a.y, b.x, b.y}; v1 = (f32x4){c.x, c.y, d.x, d.y}; }
                    if (ACT == 2) {
#pragma unroll
                        for (int j = 0; j < 4; ++j) { v0[j] = 0.5f * v0[j] * (1.0f + erff(v0[j] * 0.70710678f)); v1[j] = 0.5f * v1[j] * (1.0f + erff(v1[j] * 0.70710678f)); } }
                    u32x4 w; w.x = cvt_pk_bf16(v0[0], v0[1]); w.y = cvt_pk_bf16(v0[2], v0[3]); w.z = cvt_pk_bf16(v1[0], v1[1]); w.w = cvt_pk_bf16(v1[2], v1[3]);
                    *(u32x4*)(rowp + bj * HALF) = w; } }
    }
};

struct PanelStats {
    unsigned* xbuf;
    unsigned* cnt;
    unsigned* tmo;
    int ntn; float eps;
    unsigned code;
    __device__ __forceinline__ bool run(const f32x4 (&v)[2][2][4][2], const Unit& u, int wr, int wc, int fr, int fq, PG8_LAS unsigned char* lds, int wid, int lane) const {
        typedef float f32x2v __attribute__((ext_vector_type(2)));
        PG8_LAS f32x2v* P = (PG8_LAS f32x2v*)lds;
        PG8_LAS f32x2v* S = (PG8_LAS f32x2v*)(lds + 8192);
        PG8_LAS unsigned* flag = (PG8_LAS unsigned*)(lds + 8192 + 2048);
#pragma unroll
        for (int ai = 0; ai < 2; ++ai)
#pragma unroll
            for (int m = 0; m < 4; ++m) {
                float s = 0.f;
#pragma unroll
                for (int bj = 0; bj < 2; ++bj)
#pragma unroll
                    for (int n = 0; n < 2; ++n) { const f32x4 x = v[ai][bj][m][n]; s += (x[0] + x[1]) + (x[2] + x[3]); }
                s += __shfl_xor(s, 16); s += __shfl_xor(s, 32);
                const float mw = s * (1.0f / 64.0f); float q = 0.f;
#pragma unroll
                for (int bj = 0; bj < 2; ++bj)
#pragma unroll
                    for (int n = 0; n < 2; ++n) { const f32x4 d = v[ai][bj][m][n] - mw; q += (d[0] * d[0] + d[1] * d[1]) + (d[2] * d[2] + d[3] * d[3]); }
                q += __shfl_xor(q, 16); q += __shfl_xor(q, 32);
                if (fq == 0) P[(ai * HALF + wr * 64 + m * 16 + fr) * 4 + wc] = (f32x2v){mw, q};
            }
        asm volatile("s_waitcnt lgkmcnt(0)" ::: "memory"); __builtin_amdgcn_s_barrier(); asm volatile("" ::: "memory");
#if defined(BROKEN_NO_WAIT)
        if (blockIdx.x >= 64) { const long long t0 = clock64(); while (clock64() - t0 < 60000) __builtin_amdgcn_s_sleep(8); }
#endif
        const int row = wid * 32 + (lane & 31);
        if (lane < 32) {
            const f32x2v a = P[row * 4 + 0], b = P[row * 4 + 1], c = P[row * 4 + 2], d = P[row * 4 + 3];
            const float mt = (a.x + b.x + c.x + d.x) * 0.25f;
            const float da = a.x - mt, db = b.x - mt, dc = c.x - mt, dd = d.x - mt;
            const float m2 = (a.y + b.y) + (c.y + d.y) + 64.0f * ((da * da + db * db) + (dc * dc + dd * dd));
            unsigned long long* slot = (unsigned long long*)xbuf + ((size_t)(u.pm * BM + row) * 4 + u.pn);
            __hip_atomic_store(slot, ((unsigned long long)__float_as_uint(m2) << 32) | __float_as_uint(mt), __ATOMIC_RELAXED, __HIP_MEMORY_SCOPE_AGENT);
        }
        asm volatile("s_waitcnt vmcnt(0)" ::: "memory");
        if (lane == 0) __hip_atomic_fetch_add(cnt + 64 * u.pm, 1u, __ATOMIC_RELAXED, __HIP_MEMORY_SCOPE_AGENT);
        if (wid == 0) {
            bool dead = false; const unsigned long long t0 = __builtin_amdgcn_s_memrealtime(); const unsigned want = 8u * (unsigned)ntn;
            for (;;) {
#if defined(BROKEN_NO_WAIT)
                break;
#endif
                if ((unsigned)__builtin_amdgcn_readfirstlane(__hip_atomic_load(cnt + 64 * u.pm, __ATOMIC_RELAXED, __HIP_MEMORY_SCOPE_AGENT)) >= want) break;
                if (__builtin_amdgcn_s_memrealtime() - t0 > 2000000ull) {
                    if (lane == 0) { unsigned expect = 0u; __hip_atomic_compare_exchange_strong(tmo + 1, &expect, code | (unsigned)(u.pm & 0xff), __ATOMIC_RELAXED, __ATOMIC_RELAXED, __HIP_MEMORY_SCOPE_AGENT);
                                     __hip_atomic_store(tmo, 1u, __ATOMIC_RELAXED, __HIP_MEMORY_SCOPE_AGENT); }
                    dead = true; break; }
                __builtin_amdgcn_s_sleep(2);
            }
            __builtin_amdgcn_fence(__ATOMIC_ACQUIRE, "agent");
            if (lane == 0) flag[0] = dead ? 1u : 0u;
        }
        asm volatile("s_waitcnt vmcnt(0) lgkmcnt(0)" ::: "memory"); __builtin_amdgcn_s_barrier(); asm volatile("" ::: "memory");
        const bool bad = flag[0] != 0u;
        if (lane < 32) {
            const unsigned long long* slot = (const unsigned long long*)xbuf + (size_t)(u.pm * BM + row) * 4; float mt[4], m2[4]; float ms = 0.f;
#pragma unroll
            for (int t = 0; t < 4; ++t) { if (t < ntn) { const unsigned long long w = __hip_atomic_load(slot + t, __ATOMIC_RELAXED, __HIP_MEMORY_SCOPE_AGENT); mt[t] = __uint_as_float((unsigned)w); m2[t] = __uint_as_float((unsigned)(w >> 32)); } else { mt[t] = 0.f; m2[t] = 0.f; } ms += mt[t]; }
            const float mean = ms / (float)ntn; float q = 0.f;
#pragma unroll
            for (int t = 0; t < 4; ++t) if (t < ntn) { const float dm = mt[t] - mean; q += m2[t] + 256.0f * dm * dm; }
            S[row] = (f32x2v){mean, 1.0f / sqrtf(q / (256.0f * (float)ntn) + eps)};
        }
        asm volatile("s_waitcnt lgkmcnt(0)" ::: "memory"); __builtin_amdgcn_s_barrier(); asm volatile("" ::: "memory");
        return bad;
    }
};
struct EpiLnRes {
    static constexpr bool PERM = false, AFTER_DRAIN = true;
    const float* base; float* out; int ldc; const float* bias; PanelStats st; unsigned poison;
    __device__ __forceinline__ void refuse(size_t i0, size_t stride, int M, int N) const { const float q = __builtin_nanf(""); for (size_t i = i0; i < (size_t)M * N; i += stride) out[(i / N) * ldc + i % N] = q;
        if (i0 == 0) { unsigned expect = 0u; __hip_atomic_compare_exchange_strong(st.tmo + 1, &expect, 0x7f0u, __ATOMIC_RELAXED, __ATOMIC_RELAXED, __HIP_MEMORY_SCOPE_AGENT); __hip_atomic_store(st.tmo, 1u, __ATOMIC_RELAXED, __HIP_MEMORY_SCOPE_AGENT); } }
    __device__ __forceinline__ void fused(f32x4 (&acc)[2][2][4][2], const Unit& u, int wr, int wc, int fr, int fq, PG8_LAS unsigned char* lds, int wid, int lane) const {
        typedef float f32x2v __attribute__((ext_vector_type(2)));
        const PG8_LAS f32x2v* S = (const PG8_LAS f32x2v*)(lds + 8192);
        const int col0 = u.pn * BM + wc * 32 + 4 * fq;
#pragma unroll
        for (int bj = 0; bj < 2; ++bj)
#pragma unroll
            for (int n = 0; n < 2; ++n) { const f32x4 bv = bias ? *(const f32x4*)(bias + col0 + bj * HALF + n * 16) : (f32x4){0.f, 0.f, 0.f, 0.f};
#pragma unroll
                for (int ai = 0; ai < 2; ++ai)
#pragma unroll
                    for (int m = 0; m < 4; ++m) acc[ai][bj][m][n] += bv; }
        const bool bad = st.run(acc, u, wr, wc, fr, fq, lds, wid, lane) || poison != 0u;
        const float qnan = __builtin_nanf("");
#pragma unroll
        for (int ai = 0; ai < 2; ++ai)
#pragma unroll
            for (int m = 0; m < 4; ++m) { const int r = ai * HALF + wr * 64 + m * 16 + fr; const f32x2v sr = S[r]; const size_t off = (size_t)(u.pm * BM + r) * ldc + col0;
#pragma unroll
                for (int bj = 0; bj < 2; ++bj)
#pragma unroll
                    for (int n = 0; n < 2; ++n) { const f32x4 bs = *(const f32x4*)(base + off + bj * HALF + n * 16); f32x4 o = bs + (acc[ai][bj][m][n] - sr.x) * sr.y;
                        if (bad) o = (f32x4){qnan, qnan, qnan, qnan}; *(f32x4*)(out + off + bj * HALF + n * 16) = o; }
                asm volatile("" ::: "memory"); }
    }
};
struct EpiLnResLn {
    static constexpr bool PERM = false, AFTER_DRAIN = true;
    const float* base; float* out; bf16_t* xn; int ldc; const float* bias; PanelStats st1, st2; unsigned poison;
    __device__ __forceinline__ void refuse(size_t i0, size_t stride, int M, int N) const { const float q = __builtin_nanf(""); for (size_t i = i0; i < (size_t)M * N; i += stride) { const size_t o = (i / N) * ldc + i % N; out[o] = q; xn[o] = (bf16_t)0x7fc0u; }
        if (i0 == 0) { unsigned expect = 0u; __hip_atomic_compare_exchange_strong(st1.tmo + 1, &expect, 0x7f0u, __ATOMIC_RELAXED, __ATOMIC_RELAXED, __HIP_MEMORY_SCOPE_AGENT); __hip_atomic_store(st1.tmo, 1u, __ATOMIC_RELAXED, __HIP_MEMORY_SCOPE_AGENT); } }
    __device__ __forceinline__ void fused(f32x4 (&acc)[2][2][4][2], const Unit& u, int wr, int wc, int fr, int fq, PG8_LAS unsigned char* lds, int wid, int lane) const {
        typedef float f32x2v __attribute__((ext_vector_type(2))); typedef unsigned u32x2v __attribute__((ext_vector_type(2)));
        const PG8_LAS f32x2v* S = (const PG8_LAS f32x2v*)(lds + 8192);
        const int col0 = u.pn * BM + wc * 32 + 4 * fq;
#pragma unroll
        for (int bj = 0; bj < 2; ++bj)
#pragma unroll
            for (int n = 0; n < 2; ++n) { const f32x4 bv = bias ? *(const f32x4*)(bias + col0 + bj * HALF + n * 16) : (f32x4){0.f, 0.f, 0.f, 0.f};
#pragma unroll
                for (int ai = 0; ai < 2; ++ai)
#pragma unroll
                    for (int m = 0; m < 4; ++m) acc[ai][bj][m][n] += bv; }
        bool bad = st1.run(acc, u, wr, wc, fr, fq, lds, wid, lane) || poison != 0u;
        const float qnan = __builtin_nanf("");
#pragma unroll
        for (int ai = 0; ai < 2; ++ai)
#pragma unroll
            for (int m = 0; m < 4; ++m) { const int r = ai * HALF + wr * 64 + m * 16 + fr; const f32x2v sr = S[r]; const size_t off = (size_t)(u.pm * BM + r) * ldc + col0;
#pragma unroll
                for (int bj = 0; bj < 2; ++bj)
#pragma unroll
                    for (int n = 0; n < 2; ++n) { const f32x4 bs = *(const f32x4*)(base + off + bj * HALF + n * 16); acc[ai][bj][m][n] = bs + (acc[ai][bj][m][n] - sr.x) * sr.y; }
                asm volatile("" : "+v"(acc[ai][0][m][0]), "+v"(acc[ai][0][m][1]), "+v"(acc[ai][1][m][0]), "+v"(acc[ai][1][m][1]));
                if (m & 1) asm volatile("" ::: "memory"); }
        const bool bad1 = bad;
        bad = st2.run(acc, u, wr, wc, fr, fq, lds, wid, lane) || bad;
#pragma unroll
        for (int ai = 0; ai < 2; ++ai)
#pragma unroll
            for (int m = 0; m < 4; ++m) { const int r = ai * HALF + wr * 64 + m * 16 + fr; const f32x2v sr = S[r]; const size_t off = (size_t)(u.pm * BM + r) * ldc + col0;
#pragma unroll
                for (int bj = 0; bj < 2; ++bj)
#pragma unroll
                    for (int n = 0; n < 2; ++n) { const f32x4 x1 = acc[ai][bj][m][n]; *(f32x4*)(out + off + bj * HALF + n * 16) = bad1 ? (f32x4){qnan, qnan, qnan, qnan} : x1;
                        const f32x4 o = (x1 - sr.x) * sr.y; u32x2v w; w.x = cvt_pk_bf16(o[0], o[1]); w.y = cvt_pk_bf16(o[2], o[3]);
                        if (bad) { w.x = 0x7fc07fc0u; w.y = 0x7fc07fc0u; } *(u32x2v*)(xn + off + bj * HALF + n * 16) = w; }
                asm volatile("" ::: "memory"); }
    }
};

template <class Epi, class Sched, bool STAMP = false, bool I8 = false>
__device__ __forceinline__ void gemm_phase(PG8_LAS unsigned char* lds, const Gemm g, const Sched& S, const Epi& E, unsigned long long* stamps) {
    int tid_raw_ = threadIdx.x; asm volatile("" : "+v"(tid_raw_));
    const int tid = tid_raw_, wid = __builtin_amdgcn_readfirstlane(tid >> 6), lane = tid & 63, wr = wid >> 2, wc = wid & 3, fr = lane & 15, fq = lane >> 4;
    const int K = g.K, nt = K / BK;
    int ts_lo = 0, ts_hi = 0, nts = 0; const unsigned long long rt_entry = STAMP ? (unsigned long long)wall_clock64() : 0ull;
#define PG8_STAMP() do { if (STAMP && wid == 0 && nts < 64) { const unsigned long long _c = (unsigned long long)clock64(); \
        ts_lo = (lane == nts) ? (int)(unsigned)_c : ts_lo; ts_hi = (lane == nts) ? (int)(unsigned)(_c >> 32) : ts_hi; ++nts; } } while (0)
    PG8_STAMP();
    unsigned voffA[2], voffB[2];
#pragma unroll
    for (int i = 0; i < 2; ++i) { int R, C; stage_rc(tid * 16 + i * 8192, R, C); const int Rb = Epi::PERM ? ((R & ~31) + perm32(R & 31)) : R;
        voffA[i] = (unsigned)(R * K + C) * 2u; voffB[i] = (unsigned)(Rb * K + C) * 2u; }
    const size_t kstep = (size_t)(BK * 2);
    const size_t hstep = (size_t)HALF * K * 2;
    const size_t tstep = 2 * hstep;
    const unsigned ldsw = (unsigned)wid * 1024u;
    const int aoff = lds_byte(wr * 64 + fr, fq * 8), boff = lds_byte(wc * 32 + fr, fq * 8);
#define PG8_SA(b, h) (((b) * 2 + (h)) * HTB)
#define PG8_SB(b, h) ((4 + (b) * 2 + (h)) * HTB)
#define PG8_STAGE(bufoff, gbase, voff) do { _Pragma("unroll") for (int _i = 0; _i < 2; ++_i) \
        __builtin_amdgcn_global_load_lds((const unsigned*)((const char*)(gbase) + (voff)[_i]), (PG8_LAS unsigned*)(lds + (bufoff) + ldsw + _i * 8192), 16, 0, 0); } while (0)
#define PG8_LDA(dst, b, h) do { _Pragma("unroll") for (int m = 0; m < 4; ++m) _Pragma("unroll") for (int k = 0; k < 2; ++k) dst[m][k] = *(const PG8_LAS bf16x8*)(lds + PG8_SA(b, h) + aoff + m * 2048 + k * 1024); } while (0)
#define PG8_LDB(dst, b, h) do { _Pragma("unroll") for (int n = 0; n < 2; ++n) _Pragma("unroll") for (int k = 0; k < 2; ++k) dst[n][k] = *(const PG8_LAS bf16x8*)(lds + PG8_SB(b, h) + boff + n * 2048 + k * 1024); } while (0)
#define PG8_MMA(ai, bj, At, Bt) do { __builtin_amdgcn_s_setprio(1); _Pragma("unroll") for (int m = 0; m < 4; ++m) _Pragma("unroll") for (int n = 0; n < 2; ++n) _Pragma("unroll") for (int k = 0; k < 2; ++k) \
        { if constexpr (I8) acc[ai][bj][m][n] = __builtin_bit_cast(f32x4, __builtin_amdgcn_mfma_i32_16x16x64_i8(__builtin_bit_cast(i32x4, Bt[n][k]), __builtin_bit_cast(i32x4, At[m][k]), __builtin_bit_cast(i32x4, acc[ai][bj][m][n]), 0, 0, 0)); \
          else acc[ai][bj][m][n] = __builtin_amdgcn_mfma_f32_16x16x32_bf16(Bt[n][k], At[m][k], acc[ai][bj][m][n], 0, 0, 0); } __builtin_amdgcn_s_setprio(0); } while (0)
#define PG8_WAIT_V(n) asm volatile("s_waitcnt vmcnt(" #n ")" ::: "memory")
#define PG8_WAIT_L(n) asm volatile("s_waitcnt lgkmcnt(" #n ")" ::: "memory")
#define PG8_BAR __builtin_amdgcn_s_barrier()
#define PG8_SCHED __builtin_amdgcn_sched_barrier(0)
    Unit cur, nxt; int ui = 0;
    if (!S.next(0, cur)) return;
    f32x4 acc[2][2][4][2];
#pragma unroll
    for (int a = 0; a < 2; ++a)
#pragma unroll
        for (int b = 0; b < 2; ++b)
#pragma unroll
            for (int m = 0; m < 4; ++m)
#pragma unroll
                for (int n = 0; n < 2; ++n) acc[a][b][m][n] = (f32x4){0.f, 0.f, 0.f, 0.f};
    bf16x8 At[4][2], B0[2][2], B1[2][2];
    const char* cA = (const char*)g.A + (size_t)cur.pm * tstep; const char* cB = (const char*)g.Bt + (size_t)cur.pn * tstep;
    S.a_ready(cur);
    PG8_STAGE(PG8_SB(0, 0), cB, voffB); PG8_STAGE(PG8_SA(0, 0), cA, voffA); PG8_STAGE(PG8_SB(0, 1), cB + hstep, voffB); PG8_STAGE(PG8_SA(0, 1), cA + hstep, voffA);
    if (wr == 1) PG8_BAR;
    PG8_WAIT_V(4); PG8_BAR;
    PG8_STAGE(PG8_SB(1, 0), cB + kstep, voffB); PG8_STAGE(PG8_SA(1, 0), cA + kstep, voffA); PG8_STAGE(PG8_SB(1, 1), cB + hstep + kstep, voffB);
    PG8_WAIT_V(6); PG8_BAR;
    PG8_STAMP();
    for (;;) {
        const bool has_next = S.next(ui + 1, nxt);
        const char* nA = has_next ? (const char*)g.A + (size_t)nxt.pm * tstep : cA; const char* nB = has_next ? (const char*)g.Bt + (size_t)nxt.pn * tstep : cB;
        for (int t = 0; t < nt; t += 2) {
            const bool last = (t == nt - 2);
            const char* a1 = cA + (size_t)(t + 1) * kstep;
            const char* a2 = last ? nA : cA + (size_t)(t + 2) * kstep; const char* b2 = last ? nB : cB + (size_t)(t + 2) * kstep;
            const char* a3 = a2 + kstep; const char* b3 = b2 + kstep;
            if (last && has_next) S.a_ready(nxt);
            PG8_LDB(B0, 0, 0); PG8_SCHED; PG8_LDA(At, 0, 0); PG8_STAGE(PG8_SA(1, 1), a1 + hstep, voffA);
            PG8_WAIT_L(8); PG8_BAR; PG8_WAIT_L(0); PG8_MMA(0, 0, At, B0); PG8_BAR; PG8_SCHED;
            PG8_LDB(B1, 0, 1); PG8_STAGE(PG8_SB(0, 0), b2, voffB);
            PG8_BAR; PG8_WAIT_L(0); PG8_MMA(0, 1, At, B1); PG8_BAR;
            PG8_LDA(At, 0, 1); PG8_STAGE(PG8_SA(0, 0), a2, voffA);
            PG8_BAR; PG8_WAIT_L(0); PG8_MMA(1, 0, At, B0); PG8_BAR; PG8_SCHED;
            PG8_STAGE(PG8_SB(0, 1), b2 + hstep, voffB);
            PG8_WAIT_V(6); PG8_BAR; PG8_MMA(1, 1, At, B1); PG8_BAR;
            PG8_LDB(B0, 1, 0); PG8_SCHED; PG8_LDA(At, 1, 0); PG8_STAGE(PG8_SA(0, 1), a2 + hstep, voffA);
            PG8_WAIT_L(8); PG8_BAR; PG8_WAIT_L(0); PG8_MMA(0, 0, At, B0); PG8_BAR; PG8_SCHED;
            PG8_LDB(B1, 1, 1); PG8_STAGE(PG8_SB(1, 0), b3, voffB);
            PG8_BAR; PG8_WAIT_L(0); PG8_MMA(0, 1, At, B1); PG8_BAR;
            PG8_LDA(At, 1, 1); PG8_STAGE(PG8_SA(1, 0), a3, voffA);
            PG8_BAR; PG8_WAIT_L(0); PG8_MMA(1, 0, At, B0); PG8_BAR; PG8_SCHED;
            PG8_STAGE(PG8_SB(1, 1), b3 + hstep, voffB);
            PG8_WAIT_V(6); PG8_BAR; PG8_MMA(1, 1, At, B1); PG8_BAR;
        }
        PG8_STAMP();
        if constexpr (I8) {
#pragma unroll
            for (int a = 0; a < 2; ++a)
#pragma unroll
                for (int b = 0; b < 2; ++b)
#pragma unroll
                    for (int m = 0; m < 4; ++m)
#pragma unroll
                        for (int n = 0; n < 2; ++n) { const i32x4 q = __builtin_bit_cast(i32x4, acc[a][b][m][n]); acc[a][b][m][n] = (f32x4){(float)q.x, (float)q.y, (float)q.z, (float)q.w}; }
        }
        if constexpr (!Epi::AFTER_DRAIN) { E(acc, cur, wr, wc, fr, fq); S.done(cur); }
        PG8_STAMP();
        if (!has_next) break;
#pragma unroll
        for (int a = 0; a < 2; ++a)
#pragma unroll
            for (int b = 0; b < 2; ++b)
#pragma unroll
                for (int m = 0; m < 4; ++m)
#pragma unroll
                    for (int n = 0; n < 2; ++n) acc[a][b][m][n] = (f32x4){0.f, 0.f, 0.f, 0.f};
        cur = nxt; cA = nA; cB = nB; ++ui;
    }
    PG8_WAIT_V(0);
    if (wr == 0) PG8_BAR;
    PG8_BAR;
    if constexpr (Epi::AFTER_DRAIN) { E.fused(acc, cur, wr, wc, fr, fq, lds, wid, lane); S.done(cur); }
    PG8_STAMP();
    if (STAMP && wid == 0) { stamps[lane] = lane < nts ? (((unsigned long long)(unsigned)ts_hi << 32) | (unsigned)ts_lo) : 0ull;
        if (lane == 62) stamps[62] = rt_entry; if (lane == 63) stamps[63] = (unsigned long long)wall_clock64(); }
#undef PG8_STAMP
#undef PG8_SA
#undef PG8_SB
#undef PG8_STAGE
#undef PG8_LDA
#undef PG8_LDB
#undef PG8_MMA
#undef PG8_WAIT_V
#undef PG8_WAIT_L
#undef PG8_BAR
#undef PG8_SCHED
}
}

#ifndef ONE_LAUNCH
#define ONE_LAUNCH 1
#endif
#ifndef PROBE_G
#define PROBE_G 0
#endif
#ifndef PROBE_M
#define PROBE_M 0
#endif
#ifndef PROBE_P
#define PROBE_P 0
#endif
#ifndef PROBE_S
#define PROBE_S 0
#endif
#ifndef PROBE_A
#define PROBE_A 0
#endif
#ifndef PROBE_N
#define PROBE_N 0
#endif
#ifndef PROBE_L
#define PROBE_L 0
#endif
#ifndef PROBE_O
#define PROBE_O 0
#endif
#ifndef PROBE_PH
#define PROBE_PH -1
#endif
constexpr int NWAVES = 8, NTHR = 512;
constexpr int M_TOK = 49152, DM = 1024, SEQL = 2048, NSEQ = 24;
constexpr int CH_SEQ = 8, CH_ROWS = CH_SEQ * SEQL, NCHUNK = 3;
constexpr int QKV_N = 9216, NEXP = 16384, PQ_N = 2048, PLE_K = 256;
constexpr float DN_ALPHA = 1.681792830507429f, LN_EPS = 1e-5f;
constexpr float QSCALE = 0.12751743082459868f;
constexpr int N_PHASES = 1 + 2 * (7 + 5) + 2 * (2 + 5) ;

constexpr size_t MiB = 1u << 20;
constexpr size_t WS_CTL = 0, CTL_ZERO_BYTES = 65536;
constexpr size_t WS_WQKV = 1 * MiB, WS_WO = 37 * MiB, WS_WCIN = 41 * MiB, WS_WCOUT = 53 * MiB, WS_WPQ = 57 * MiB, WS_SK = 73 * MiB, WS_WPP = 75 * MiB, WS_WG = 77 * MiB;
constexpr size_t WS_ROPE = 85 * MiB, WS_U = 86 * MiB, WS_V = 214 * MiB, WS_PB = 342 * MiB, WS_A1 = 438 * MiB, WS_A2 = 534 * MiB, WS_R1 = 630 * MiB, WS_R2 = 918 * MiB, WS_END = 1016 * MiB;
constexpr size_t WS_A3 = WS_V;
constexpr size_t WS_USC = WS_ROPE + 256 * 1024, WS_VSC = WS_ROPE + 512 * 1024;
constexpr size_t R1_H = 0, R1_GB = 96 * MiB, R1_QP = 0, R1_PP = 192 * MiB;
constexpr size_t WS_A3Q = 160 * MiB;
constexpr size_t WS_A1Q = WS_R2 + 50 * MiB;
constexpr size_t WS_SA1 = 128 * 1024, WS_SA3 = 384 * 1024;
constexpr size_t WS_A2Q = 214 * MiB;
constexpr size_t WS_WSQKV = 704 * 1024, WS_WSCIN = 800 * 1024;
constexpr size_t WS_WSPQ = 832 * 1024;
constexpr float ACT_Q = 25.0f, ACT_S = 0.04f;
constexpr size_t WS_WSC = 640 * 1024;
constexpr size_t R2_OG = 0, R2_LSE = 96 * MiB, R2_SEL = 0;
constexpr int CW_BAR = 1024;

constexpr int SCR_BYTES = 152064, MISC_OFF = SCR_BYTES, LDS_BYTES = SCR_BYTES + 512;

#define GAS __attribute__((address_space(1)))
#define LAS __attribute__((address_space(3)))
typedef unsigned short bf16;
typedef unsigned v4u __attribute__((ext_vector_type(4)));
typedef unsigned v2u __attribute__((ext_vector_type(2)));
typedef float f32x4 __attribute__((ext_vector_type(4)));
typedef float f32x2 __attribute__((ext_vector_type(2)));
typedef short bf16x8 __attribute__((ext_vector_type(8)));
typedef __bf16 bf16x2_t __attribute__((ext_vector_type(2)));

__device__ __forceinline__ unsigned f2bf(float f) { unsigned u = __builtin_bit_cast(unsigned, f); return (u + 0x7fffu + ((u >> 16) & 1u)) >> 16; }
__device__ __forceinline__ unsigned pk2(float lo, float hi) { unsigned r; asm("v_cvt_pk_bf16_f32 %0, %1, %2" : "=v"(r) : "v"(lo), "v"(hi)); return r; }
__device__ __forceinline__ float bflo(unsigned w) { return __builtin_bit_cast(float, w << 16); }
__device__ __forceinline__ float bfhi(unsigned w) { return __builtin_bit_cast(float, w & 0xffff0000u); }
__device__ __forceinline__ float dot2bf(unsigned a, unsigned b, float acc) { return __builtin_amdgcn_fdot2_f32_bf16(__builtin_bit_cast(bf16x2_t, a), __builtin_bit_cast(bf16x2_t, b), acc, false); }
__device__ __forceinline__ float wave_sum(float v) {
#pragma unroll
    for (int o = 1; o < 64; o <<= 1) v += __shfl_xor(v, o);
    return v;
}
__device__ __forceinline__ float wave_max(float v) {
#pragma unroll
    for (int o = 1; o < 64; o <<= 1) v = fmaxf(v, __shfl_xor(v, o));
    return v;
}
__device__ __forceinline__ float row_scale_i8(const float (&v)[16], float& inv) {
    float ax = 0.f;
#pragma unroll
    for (int e = 0; e < 16; ++e) ax = fmaxf(ax, fabsf(v[e]));
    ax = wave_max(ax);
    const float sc = ax > 0.f ? ax * (1.0f / 127.0f) : 1.0f; inv = 1.0f / sc; return sc;
}
__device__ __forceinline__ unsigned pack4_i8_sat(float a, float b, float c, float d, float inv) {
    const int q0 = (int)rintf(fminf(fmaxf(a * inv, -127.f), 127.f)), q1 = (int)rintf(fminf(fmaxf(b * inv, -127.f), 127.f)), q2 = (int)rintf(fminf(fmaxf(c * inv, -127.f), 127.f)), q3 = (int)rintf(fminf(fmaxf(d * inv, -127.f), 127.f));
    return (unsigned)(q0 & 0xff) | ((unsigned)(q1 & 0xff) << 8) | ((unsigned)(q2 & 0xff) << 16) | ((unsigned)q3 << 24);
}
__device__ __forceinline__ unsigned pack4_i8(float a, float b, float c, float d, float inv) {
    const int q0 = (int)rintf(a * inv), q1 = (int)rintf(b * inv), q2 = (int)rintf(c * inv), q3 = (int)rintf(d * inv);
    return (unsigned)(q0 & 0xff) | ((unsigned)(q1 & 0xff) << 8) | ((unsigned)(q2 & 0xff) << 16) | ((unsigned)q3 << 24);
}

#define XB_TMO      128
#define XB_XCNT(j)  (256  + 64 * (j))
#define XB_XSUB(j)  (1280 + 64 * (j))
#define XB_XGEN(j)  (2304 + 64 * (j))
#define XB_TOP      3328
#define XB_TOPGEN   3392
#define XCD_BAR_WORDS 3456
#define XB_SPIN_CAP (1u << 21)
__device__ __forceinline__ unsigned xb_ld(unsigned* p)              { return __hip_atomic_load(p, __ATOMIC_RELAXED, __HIP_MEMORY_SCOPE_AGENT); }
__device__ __forceinline__ unsigned xb_add(unsigned* p, unsigned v) { return __hip_atomic_fetch_add(p, v, __ATOMIC_RELAXED, __HIP_MEMORY_SCOPE_AGENT); }
__device__ __forceinline__ unsigned xb_xcc_id() { return (unsigned)__builtin_amdgcn_s_getreg((3 << 11) | 20) & 0xFu; }
#define XB_SPIN(cond, bar) do { unsigned _sp = 0; while (cond) { __builtin_amdgcn_s_sleep(1); \
    if ((++_sp & 255u) == 0u) { if (xb_ld(&(bar)[XB_TMO])) break; if (_sp > XB_SPIN_CAP) { atomicAdd(&(bar)[XB_TMO], 1u); break; } } } } while (0)
struct XcdBarrier { unsigned* bar; unsigned x; volatile LAS unsigned* st; };
__device__ __forceinline__ XcdBarrier xcd_barrier_post(unsigned* bar, volatile LAS unsigned* st) {
    XcdBarrier b; b.bar = bar; b.x = xb_xcc_id(); b.st = st;
    if (threadIdx.x == 0) (void)xb_add(&bar[XB_XCNT(b.x)], 1u);
    return b;
}
__device__ __forceinline__ void xcd_barrier_complete(unsigned* bar, unsigned x, unsigned& nloc, unsigned& nx) {
    const unsigned G = gridDim.x * gridDim.y * gridDim.z;
    unsigned sum, cnt, mine, sp = 0u;
    for (;;) {
        sum = 0u; cnt = 0u; mine = 0u;
#pragma unroll
        for (unsigned j = 0; j < 16; ++j) { const unsigned c = xb_ld(&bar[XB_XCNT(j)]); sum += c; cnt += (c > 0u) ? 1u : 0u; mine = (j == x) ? c : mine; }
        if (sum == G) break;
        __builtin_amdgcn_s_sleep(1);
        if ((++sp & 255u) == 0u) { if (xb_ld(&bar[XB_TMO])) break; if (sp > XB_SPIN_CAP) { atomicAdd(&bar[XB_TMO], 1u); break; } }
    }
    nloc = mine > 0u ? mine : 1u; nx = cnt > 0u ? cnt : 1u;
}
__device__ __forceinline__ void xcd_barrier(const XcdBarrier& b) {
    asm volatile("s_waitcnt vmcnt(0)" ::: "memory");
    __syncthreads();
    if (threadIdx.x == 0) {
        unsigned* bar = b.bar;
        __builtin_amdgcn_s_waitcnt(0);
        unsigned nloc = b.st[0], nx = b.st[1];
        if (nloc == 0u) { xcd_barrier_complete(bar, b.x, nloc, nx); b.st[0] = nloc; b.st[1] = nx; }
        const unsigned old = xb_add(&bar[XB_XSUB(b.x)], 1u);
        const unsigned gen = old / nloc;
        if (old + 1u == (gen + 1u) * nloc) {
            __builtin_amdgcn_fence(__ATOMIC_RELEASE, "agent");
            asm volatile("s_waitcnt vmcnt(0)" ::: "memory");
            const unsigned og = xb_add(&bar[XB_TOP], 1u);
            const unsigned tg = og / nx;
            if (og + 1u == (tg + 1u) * nx) xb_add(&bar[XB_TOPGEN], 1u);
            else XB_SPIN(xb_ld(&bar[XB_TOPGEN]) == tg, bar);
            __builtin_amdgcn_fence(__ATOMIC_ACQUIRE, "agent");
            xb_add(&bar[XB_XGEN(b.x)], 1u);
            asm volatile("s_waitcnt vmcnt(0)" ::: "memory");
        } else {
            XB_SPIN(xb_ld(&bar[XB_XGEN(b.x)]) == gen, bar);
            __builtin_amdgcn_fence(__ATOMIC_ACQUIRE, "agent");
            asm volatile("s_waitcnt vmcnt(0)" ::: "memory");
        }
    }
    __syncthreads();
}

struct EpiResid {
    static constexpr bool PERM = true, AFTER_DRAIN = false;
    const bf16* XR; bf16* Z; const float* SA; const float* SB;
    __device__ __forceinline__ void operator()(const f32x4 (&acc)[2][2][4][2], const pg8::Unit& u, int wr, int wc, int fr, int fq) const {
        const int row0 = u.pm * 256 + wr * 64 + fr, col0 = u.pn * 256 + wc * 32 + 8 * fq;
        f32x4 sbv[2][2];
#pragma unroll
        for (int bj = 0; bj < 2; ++bj) { sbv[bj][0] = *(const f32x4*)(SB + col0 + bj * 128); sbv[bj][1] = *(const f32x4*)(SB + col0 + bj * 128 + 4); }
#pragma unroll
        for (int ai = 0; ai < 2; ++ai) {
            v4u xv[4][2]; float sr[4];
#pragma unroll
            for (int m = 0; m < 4; ++m) { sr[m] = SA[row0 + ai * 128 + m * 16];
#pragma unroll
                for (int bj = 0; bj < 2; ++bj) xv[m][bj] = *(const v4u*)(XR + (size_t)(row0 + ai * 128 + m * 16) * DM + col0 + bj * 128); }
#pragma unroll
            for (int m = 0; m < 4; ++m)
#pragma unroll
                for (int bj = 0; bj < 2; ++bj) { const v4u x = xv[m][bj]; const f32x4 a0 = acc[ai][bj][m][0] * (sbv[bj][0] * sr[m]), a1 = acc[ai][bj][m][1] * (sbv[bj][1] * sr[m]); v4u w;
                    w.x = pk2(bflo(x.x) * DN_ALPHA + a0.x, bfhi(x.x) * DN_ALPHA + a0.y); w.y = pk2(bflo(x.y) * DN_ALPHA + a0.z, bfhi(x.y) * DN_ALPHA + a0.w);
                    w.z = pk2(bflo(x.z) * DN_ALPHA + a1.x, bfhi(x.z) * DN_ALPHA + a1.y); w.w = pk2(bflo(x.w) * DN_ALPHA + a1.z, bfhi(x.w) * DN_ALPHA + a1.w);
                    *(v4u*)(Z + (size_t)(row0 + ai * 128 + m * 16) * DM + col0 + bj * 128) = w; }
        }
    }
};
struct EpiGate {
    static constexpr bool PERM = true, AFTER_DRAIN = false;
    const bf16* XR; const bf16* PP; bf16* XB; float* OUT; const float* SA; const float* SB; unsigned char* XQ;
    __device__ __forceinline__ void operator()(const f32x4 (&acc)[2][2][4][2], const pg8::Unit& u, int wr, int wc, int fr, int fq) const {
        const int row0 = u.pm * 256 + wr * 64 + fr, col0 = u.pn * 256 + wc * 32 + 8 * fq;
        f32x4 sbv[2][2];
#pragma unroll
        for (int bj = 0; bj < 2; ++bj) { sbv[bj][0] = *(const f32x4*)(SB + col0 + bj * 128); sbv[bj][1] = *(const f32x4*)(SB + col0 + bj * 128 + 4); }
#pragma unroll
        for (int ai = 0; ai < 2; ++ai)
#pragma unroll
        for (int mh = 0; mh < 2; ++mh) {
            v4u xv[2][2], pv[2][2]; float sr[2];
#pragma unroll
            for (int mm = 0; mm < 2; ++mm) { const int m = 2 * mh + mm; sr[mm] = SA[row0 + ai * 128 + m * 16];
#pragma unroll
                for (int bj = 0; bj < 2; ++bj) { const size_t o = (size_t)(row0 + ai * 128 + m * 16) * DM + col0 + bj * 128; xv[mm][bj] = *(const v4u*)(XR + o); pv[mm][bj] = *(const v4u*)(PP + o); } }
#pragma unroll
            for (int mm = 0; mm < 2; ++mm)
#pragma unroll
                for (int bj = 0; bj < 2; ++bj) { const int m = 2 * mh + mm; const size_t o = (size_t)(row0 + ai * 128 + m * 16) * DM + col0 + bj * 128; const v4u x = xv[mm][bj], p2 = pv[mm][bj];
                    const f32x4 a0 = acc[ai][bj][m][0] * (sbv[bj][0] * sr[mm]), a1 = acc[ai][bj][m][1] * (sbv[bj][1] * sr[mm]);
                    float r[8];
#define SG_(pv, av) ((pv) * __builtin_amdgcn_rcpf(1.0f + __builtin_amdgcn_exp2f((av) * -1.44269504089f)))
                    r[0] = bflo(x.x) + SG_(bflo(p2.x), a0.x); r[1] = bfhi(x.x) + SG_(bfhi(p2.x), a0.y); r[2] = bflo(x.y) + SG_(bflo(p2.y), a0.z); r[3] = bfhi(x.y) + SG_(bfhi(p2.y), a0.w);
                    r[4] = bflo(x.z) + SG_(bflo(p2.z), a1.x); r[5] = bfhi(x.z) + SG_(bfhi(p2.z), a1.y); r[6] = bflo(x.w) + SG_(bflo(p2.w), a1.z); r[7] = bfhi(x.w) + SG_(bfhi(p2.w), a1.w);
#undef SG_
                    if (OUT) { *(f32x4*)(OUT + o) = (f32x4){r[0], r[1], r[2], r[3]}; *(f32x4*)(OUT + o + 4) = (f32x4){r[4], r[5], r[6], r[7]}; }
                    else { v4u w; w.x = pk2(r[0], r[1]); w.y = pk2(r[2], r[3]); w.z = pk2(r[4], r[5]); w.w = pk2(r[6], r[7]); *(v4u*)(XB + o) = w;
                           v2u q2; q2.x = pack4_i8_sat(r[0], r[1], r[2], r[3], ACT_Q); q2.y = pack4_i8_sat(r[4], r[5], r[6], r[7], ACT_Q); *(v2u*)(XQ + o) = q2; } }
        }
    }
};
struct EpiCin {
    static constexpr bool PERM = true, AFTER_DRAIN = false;
    bf16* H; bf16* GB; const float* SB;
    __device__ __forceinline__ void operator()(const f32x4 (&acc_)[2][2][4][2], const pg8::Unit& u, int wr, int wc, int fr, int fq) const {
        const int row0 = u.pm * 256 + wr * 64 + fr;
        f32x4 acc[2][2][4][2];
        {   const int cg = u.pn * 256 + wc * 32 + 8 * fq;
#pragma unroll
            for (int bj = 0; bj < 2; ++bj) { const f32x4 s0 = *(const f32x4*)(SB + cg + bj * 128) * ACT_S, s1 = *(const f32x4*)(SB + cg + bj * 128 + 4) * ACT_S;
#pragma unroll
                for (int ai = 0; ai < 2; ++ai)
#pragma unroll
                    for (int m = 0; m < 4; ++m) { acc[ai][bj][m][0] = acc_[ai][bj][m][0] * s0; acc[ai][bj][m][1] = acc_[ai][bj][m][1] * s1; } } }
        if (u.pn < 8) {
            const int c0 = u.pn * 128 + wc * 32 + 8 * fq;
#pragma unroll
            for (int ai = 0; ai < 2; ++ai)
#pragma unroll
                for (int m = 0; m < 4; ++m) { const f32x4 g0 = acc[ai][0][m][0], g1 = acc[ai][0][m][1], x0 = acc[ai][1][m][0], x1 = acc[ai][1][m][1];
                    v4u w; w.x = pk2(g0.x * x0.x, g0.y * x0.y); w.y = pk2(g0.z * x0.z, g0.w * x0.w); w.z = pk2(g1.x * x1.x, g1.y * x1.y); w.w = pk2(g1.z * x1.z, g1.w * x1.w);
                    *(v4u*)(H + (size_t)(row0 + ai * 128 + m * 16) * DM + c0) = w; }
        } else {
            const int c0 = (u.pn - 8) * 256 + wc * 32 + 8 * fq;
#pragma unroll
            for (int ai = 0; ai < 2; ++ai)
#pragma unroll
                for (int m = 0; m < 4; ++m)
#pragma unroll
                    for (int bj = 0; bj < 2; ++bj) { const f32x4 v0 = acc[ai][bj][m][0], v1 = acc[ai][bj][m][1];
                        v4u w; w.x = pk2(v0.x, v0.y); w.y = pk2(v0.z, v0.w); w.z = pk2(v1.x, v1.y); w.w = pk2(v1.z, v1.w);
                        *(v4u*)(GB + (size_t)(row0 + ai * 128 + m * 16) * DM + c0 + bj * 128) = w; }
        }
    }
};
struct EpiQKV {
    static constexpr bool PERM = true, AFTER_DRAIN = false;
    bf16* P; const f32x2* rope; const float* SB;
    __device__ __forceinline__ void operator()(const f32x4 (&acc)[2][2][4][2], const pg8::Unit& u, int wr, int wc, int fr, int fq) const {
        const int g = u.pn / 12, t = (u.pn % 12) >> 2, hp = u.pn & 3;
        f32x4 sv[2][2];
        {   const float k_ = ((t == 0) ? QSCALE : 1.0f) * ACT_S; const int cg = u.pn * 256 + wc * 32 + 8 * fq;
#pragma unroll
            for (int bj = 0; bj < 2; ++bj) { sv[bj][0] = *(const f32x4*)(SB + cg + bj * 128) * k_; sv[bj][1] = *(const f32x4*)(SB + cg + bj * 128 + 4) * k_; } }
        const int sq = u.pm >> 3;
        const int tok0 = (u.pm & 7) * 256 + wr * 64 + fr;
        const int d0 = wc * 32 + 8 * fq;
        const bool rot = (t < 2) && (wc == 0);
        float co[8], si[8], c16[8], s16[8], c80[8], s80[8];
        if (rot) {
            const f32x4* r0 = (const f32x4*)(rope + tok0 * 16 + 8 * (fq & 1)); const f32x4* r16 = (const f32x4*)(rope + 16 * 16 + 8 * (fq & 1)); const f32x4* r80 = (const f32x4*)(rope + 80 * 16 + 8 * (fq & 1));
#pragma unroll
            for (int q = 0; q < 4; ++q) { const f32x4 a = r0[q], b = r16[q], c = r80[q];
                co[2 * q] = a.x; si[2 * q] = a.y; co[2 * q + 1] = a.z; si[2 * q + 1] = a.w; c16[2 * q] = b.x; s16[2 * q] = b.y; c16[2 * q + 1] = b.z; s16[2 * q + 1] = b.w; c80[2 * q] = c.x; s80[2 * q] = c.y; c80[2 * q + 1] = c.z; s80[2 * q + 1] = c.w; }
        }
#pragma unroll
        for (int ai = 0; ai < 2; ++ai)
#pragma unroll
            for (int m = 0; m < 4; ++m) {
                const int tok = tok0 + ai * 128 + m * 16;
#pragma unroll
                for (int bj = 0; bj < 2; ++bj) {
                    float v[8];
#pragma unroll
                    for (int n = 0; n < 2; ++n) { const f32x4 a = acc[ai][bj][m][n] * sv[bj][n]; v[4 * n] = a.x; v[4 * n + 1] = a.y; v[4 * n + 2] = a.z; v[4 * n + 3] = a.w; }
                    if (rot) {
#pragma unroll
                        for (int e = 0; e < 8; ++e) { const auto sw = __builtin_amdgcn_permlane32_swap(__builtin_bit_cast(unsigned, v[e]), __builtin_bit_cast(unsigned, v[e]), false, false);
                            const float pr = __builtin_bit_cast(float, (fq < 2) ? sw[1] : sw[0]); v[e] = (fq < 2) ? (v[e] * co[e] - pr * si[e]) : (v[e] * co[e] + pr * si[e]); }
                    }
                    const int h = 2 * hp + bj;
                    const size_t plane = (size_t)(((sq * 3 + g) * 3 + t) * 8 + h);
                    if (t == 2) {
                        v2u w8; int q_ = 0; q_ = __builtin_amdgcn_cvt_pk_fp8_f32(v[0], v[1], q_, false); q_ = __builtin_amdgcn_cvt_pk_fp8_f32(v[2], v[3], q_, true); w8.x = (unsigned)q_;
                        q_ = 0; q_ = __builtin_amdgcn_cvt_pk_fp8_f32(v[4], v[5], q_, false); q_ = __builtin_amdgcn_cvt_pk_fp8_f32(v[6], v[7], q_, true); w8.y = (unsigned)q_;
                        *(v2u*)((unsigned char*)(P + plane * SEQL * 128) + (size_t)tok * 128 + d0) = w8;
                    } else {
                    v4u w; w.x = pk2(v[0], v[1]); w.y = pk2(v[2], v[3]); w.z = pk2(v[4], v[5]); w.w = pk2(v[6], v[7]);
                    *(v4u*)(P + (plane * SEQL + tok) * 128 + d0) = w; }
                }
                if (rot && !(ai == 1 && m == 3)) {
#pragma unroll
                    for (int e = 0; e < 8; ++e) { const float cd = (m < 3) ? c16[e] : c80[e], sd = (m < 3) ? s16[e] : s80[e]; const float cn = co[e] * cd - si[e] * sd, sn = si[e] * cd + co[e] * sd; co[e] = cn; si[e] = sn; }
                }
            }
    }
};
struct EpiQp {
    static constexpr bool PERM = true, AFTER_DRAIN = false;
    bf16* O; const float* SA; const float* SB;
    __device__ __forceinline__ void operator()(const f32x4 (&acc)[2][2][4][2], const pg8::Unit& u, int wr, int wc, int fr, int fq) const {
        const int row0 = u.pm * 256 + wr * 64 + fr, col0 = u.pn * 256 + wc * 32 + 8 * fq;
        f32x4 sbv[2][2];
#pragma unroll
        for (int bj = 0; bj < 2; ++bj) { sbv[bj][0] = *(const f32x4*)(SB + col0 + bj * 128); sbv[bj][1] = *(const f32x4*)(SB + col0 + bj * 128 + 4); }
#pragma unroll
        for (int ai = 0; ai < 2; ++ai)
#pragma unroll
            for (int m = 0; m < 4; ++m) { const float sr = SA[row0 + ai * 128 + m * 16];
#pragma unroll
                for (int bj = 0; bj < 2; ++bj) { const f32x4 a0 = acc[ai][bj][m][0] * (sbv[bj][0] * sr), a1 = acc[ai][bj][m][1] * (sbv[bj][1] * sr);
                    v4u w; w.x = pk2(a0.x, a0.y); w.y = pk2(a0.z, a0.w); w.z = pk2(a1.x, a1.y); w.w = pk2(a1.z, a1.w);
                    *(v4u*)(O + (size_t)(row0 + ai * 128 + m * 16) * PQ_N + col0 + bj * 128) = w; } }
    }
};
struct EpiNull {
    static constexpr bool PERM = true, AFTER_DRAIN = false;
    __device__ __forceinline__ void operator()(const f32x4 (&acc)[2][2][4][2], const pg8::Unit&, int, int, int, int) const {
#pragma unroll
        for (int a = 0; a < 2; ++a)
#pragma unroll
            for (int b = 0; b < 2; ++b)
#pragma unroll
                for (int m = 0; m < 4; ++m)
#pragma unroll
                    for (int n = 0; n < 2; ++n) asm volatile("" :: "v"(acc[a][b][m][n]));
    }
};
struct Args { const float* in[19]; float* out; unsigned char* ws; float inv_freq[16]; int ph_lo, ph_hi; };

__device__ __forceinline__ void transpose_item(const float* W, int K, int N, bf16* WT, int k0, int n0, int drow0, LAS float* scr, int lane) {
#pragma unroll 8
    for (int i = 0; i < 32; ++i) { const int kk = 2 * i + (lane >> 5); scr[kk * 33 + (lane & 31)] = W[(size_t)(k0 + kk) * N + n0 + (lane & 31)]; }
    asm volatile("s_waitcnt lgkmcnt(0)" ::: "memory");
    const int c = lane & 7;
#pragma unroll
    for (int j = 0; j < 4; ++j) { const int n = (lane >> 3) + 8 * j; const LAS float* s = scr + (8 * c) * 33 + n;
        v4u o; o.x = pk2(s[0 * 33], s[1 * 33]); o.y = pk2(s[2 * 33], s[3 * 33]); o.z = pk2(s[4 * 33], s[5 * 33]); o.w = pk2(s[6 * 33], s[7 * 33]);
        *(v4u*)(WT + (size_t)(drow0 + n) * K + k0 + 8 * c) = o; }
    asm volatile("s_waitcnt lgkmcnt(0)" ::: "memory");
}
__device__ __forceinline__ void cvt_range(const float* src, bf16* dst, size_t n8, size_t g0, size_t gs) {
    size_t i = g0;
    for (; i + 3 * gs < n8; i += 4 * gs) {
        f32x4 a[4], b[4];
#pragma unroll
        for (int q = 0; q < 4; ++q) { a[q] = ((const f32x4*)src)[2 * (i + q * gs)]; b[q] = ((const f32x4*)src)[2 * (i + q * gs) + 1]; }
#pragma unroll
        for (int q = 0; q < 4; ++q) { v4u o; o.x = pk2(a[q].x, a[q].y); o.y = pk2(a[q].z, a[q].w); o.z = pk2(b[q].x, b[q].y); o.w = pk2(b[q].z, b[q].w); ((v4u*)dst)[i + q * gs] = o; }
    }
    for (; i < n8; i += gs) { const f32x4 a = ((const f32x4*)src)[2 * i], b = ((const f32x4*)src)[2 * i + 1];
        v4u o; o.x = pk2(a.x, a.y); o.y = pk2(a.z, a.w); o.z = pk2(b.x, b.y); o.w = pk2(b.z, b.w); ((v4u*)dst)[i] = o; }
}
__device__ __forceinline__ void cvt_copy_range(const float* src, bf16* dst, float* cpy, size_t n8, size_t g0, size_t gs) {
    size_t i = g0;
    for (; i + 3 * gs < n8; i += 4 * gs) {
        f32x4 a[4], b[4];
#pragma unroll
        for (int q = 0; q < 4; ++q) { a[q] = ((const f32x4*)src)[2 * (i + q * gs)]; b[q] = ((const f32x4*)src)[2 * (i + q * gs) + 1]; }
#pragma unroll
        for (int q = 0; q < 4; ++q) { v4u o; o.x = pk2(a[q].x, a[q].y); o.y = pk2(a[q].z, a[q].w); o.z = pk2(b[q].x, b[q].y); o.w = pk2(b[q].z, b[q].w); ((v4u*)dst)[i + q * gs] = o;
            ((f32x4*)cpy)[2 * (i + q * gs)] = a[q]; ((f32x4*)cpy)[2 * (i + q * gs) + 1] = b[q]; }
    }
    for (; i < n8; i += gs) { const f32x4 a = ((const f32x4*)src)[2 * i], b = ((const f32x4*)src)[2 * i + 1];
        v4u o; o.x = pk2(a.x, a.y); o.y = pk2(a.z, a.w); o.z = pk2(b.x, b.y); o.w = pk2(b.z, b.w); ((v4u*)dst)[i] = o; ((f32x4*)cpy)[2 * i] = a; ((f32x4*)cpy)[2 * i + 1] = b; }
}
__device__ __forceinline__ void cvt_rows_fp8(const float* src, unsigned char* dst, float* sc, int nrows, int lane, int gw, int NGW) {
    for (int r0 = gw; r0 < nrows; r0 += 4 * NGW) {
        f32x4 v[4][4]; float m[4];
#pragma unroll
        for (int j = 0; j < 4; ++j) { const int r = r0 + j * NGW; const f32x4* p = (const f32x4*)(src + (size_t)(r < nrows ? r : r0) * DM + 16 * lane);
#pragma unroll
            for (int q = 0; q < 4; ++q) v[j][q] = p[q]; }
#pragma unroll
        for (int j = 0; j < 4; ++j) { float mm = 0.f;
#pragma unroll
            for (int q = 0; q < 4; ++q) mm = fmaxf(mm, fmaxf(fmaxf(fabsf(v[j][q].x), fabsf(v[j][q].y)), fmaxf(fabsf(v[j][q].z), fabsf(v[j][q].w))));
            m[j] = mm; }
#pragma unroll
        for (int o = 1; o < 64; o <<= 1) {
#pragma unroll
            for (int j = 0; j < 4; ++j) m[j] = fmaxf(m[j], __shfl_xor(m[j], o)); }
#pragma unroll
        for (int j = 0; j < 4; ++j) { const int r = r0 + j * NGW; if (r < nrows) {
            const float scale = (m[j] > 0.f) ? 416.0f / m[j] : 1.0f;
            v4u o;
#pragma unroll
            for (int q = 0; q < 4; ++q) { int w = 0; w = __builtin_amdgcn_cvt_pk_fp8_f32(v[j][q].x * scale, v[j][q].y * scale, w, false); w = __builtin_amdgcn_cvt_pk_fp8_f32(v[j][q].z * scale, v[j][q].w * scale, w, true); o[q] = (unsigned)w; }
            *(v4u*)(dst + (size_t)r * DM + 16 * lane) = o;
            if (lane == 0) sc[r] = 1.0f / scale; } }
    }
}
constexpr int T4_ROW = 1152;
__device__ __forceinline__ void quant16_i4(const f32x4 (&v)[4], unsigned& w0, unsigned& w1, unsigned& sc16) {
    float m = 0.f;
#pragma unroll
    for (int q = 0; q < 4; ++q) m = fmaxf(m, fmaxf(fmaxf(fabsf(v[q].x), fabsf(v[q].y)), fmaxf(fabsf(v[q].z), fabsf(v[q].w))));
    const float s1k = fmaxf(m * (1024.0f / 7.5f), 0.015625f);
    sc16 = (unsigned)__builtin_amdgcn_cvt_pk_fp8_f32(s1k, s1k, 0, false) & 0xffu;
    const f32x2 dec = __builtin_amdgcn_cvt_pk_f32_fp8((int)sc16, false);
    const float inv = 1024.0f / dec.x;
    unsigned w[2] = {0u, 0u};
#pragma unroll
    for (int q = 0; q < 4; ++q) { const float e[4] = {v[q].x, v[q].y, v[q].z, v[q].w};
#pragma unroll
        for (int j = 0; j < 4; ++j) { float t = floorf(e[j] * inv + 8.0f); t = fminf(fmaxf(t, 0.f), 15.f); w[q >> 1] |= (unsigned)t << (4 * (4 * (q & 1) + j)); } }
    w0 = w[0]; w1 = w[1];
}
#ifndef FP4_LO_FIRST
#define FP4_LO_FIRST 1
#endif
__device__ __forceinline__ void quant16_fp4(const f32x4 (&v)[4], unsigned& w0, unsigned& w1, unsigned& sc16) {
    float m = 0.f;
#pragma unroll
    for (int q = 0; q < 4; ++q) m = fmaxf(m, fmaxf(fmaxf(fabsf(v[q].x), fabsf(v[q].y)), fmaxf(fabsf(v[q].z), fabsf(v[q].w))));
    const float s1k = fmaxf(m * (1024.0f / 6.0f), 0.015625f);
    sc16 = (unsigned)__builtin_amdgcn_cvt_pk_fp8_f32(s1k, s1k, 0, false) & 0xffu;
    const f32x2 dec = __builtin_amdgcn_cvt_pk_f32_fp8((int)sc16, false);
    const float inv = 1024.0f / dec.x;
    unsigned w[2] = {0u, 0u};
#pragma unroll
    for (int q = 0; q < 4; ++q) { const float e[4] = {v[q].x, v[q].y, v[q].z, v[q].w};
#pragma unroll
        for (int j = 0; j < 4; ++j) { const float y = e[j] * inv, ay = fabsf(y);
            unsigned c = (ay > 0.25f) + (ay > 0.75f) + (ay > 1.25f) + (ay > 1.75f) + (ay > 2.5f) + (ay > 3.5f) + (ay > 5.0f);
            c |= (y < 0.f) ? 8u : 0u;
            const int el = 4 * (q & 1) + j;
            const int nib = FP4_LO_FIRST ? el : (el ^ 1);
            w[q >> 1] |= c << (4 * nib); } }
    w0 = w[0]; w1 = w[1];
}
__device__ __forceinline__ void quant_rows_i4(const float* U, const float* V, unsigned char* dst, int nrows, int lane, int gw, int NGW) {
    for (int r0 = gw; r0 < nrows; r0 += 2 * NGW) {
        f32x4 uv[2][4], vv[2][4];
#pragma unroll
        for (int j = 0; j < 2; ++j) { const int r = (r0 + j * NGW < nrows) ? r0 + j * NGW : r0; const f32x4* pu = (const f32x4*)(U + (size_t)r * DM + 16 * lane); const f32x4* pv = (const f32x4*)(V + (size_t)r * DM + 16 * lane);
#pragma unroll
            for (int q = 0; q < 4; ++q) { uv[j][q] = pu[q]; vv[j][q] = pv[q]; } }
#pragma unroll
        for (int j = 0; j < 2; ++j) { const int r = r0 + j * NGW; if (r < nrows) {
            unsigned u0, u1, v0, v1, su, sv; quant16_i4(uv[j], u0, u1, su); quant16_fp4(vv[j], v0, v1, sv); const v4u o = {u0, u1, v0, v1};
            unsigned char* row = dst + (size_t)r * T4_ROW;
            *((v4u*)row + lane) = o; *((unsigned short*)(row + 1024) + lane) = (unsigned short)(su | (sv << 8)); } }
    }
}
__device__ __forceinline__ void sincos_d(double x, double& s, double& c) {
    const double k = rint(x * 0.15915494309189533576888376337251); const double r = x - k * 6.283185307179586476925286766559; const double r2 = r * r;
    double sp = 1.0, cp = 1.0;
    for (int n = 14; n >= 1; --n) { sp = 1.0 - sp * r2 / ((2.0 * n) * (2.0 * n + 1.0)); cp = 1.0 - cp * r2 / ((2.0 * n - 1.0) * (2.0 * n)); }
    s = r * sp; c = cp;
}
__device__ __forceinline__ void cvt_range_i8(const float* src, unsigned char* dst, size_t n8, size_t g0, size_t gs) {
    for (size_t e = g0; e < n8; e += gs) { const f32x4 a = *((const f32x4*)src + 2 * e), b = *((const f32x4*)src + 2 * e + 1);
        v2u w; w.x = pack4_i8_sat(a.x, a.y, a.z, a.w, ACT_Q); w.y = pack4_i8_sat(b.x, b.y, b.z, b.w, ACT_Q); *((v2u*)dst + e) = w; }
}
__device__ __forceinline__ void prologue(const Args& a, unsigned char* ws, LAS unsigned char* lds, int tid, int lane, int wave, int bid, int G) {
    const int gw = bid * NWAVES + wave, NGW = G * NWAVES;
    LAS float* scr = (LAS float*)(lds + wave * 16384);
    {
        LAS float* red = (LAS float*)(lds + 8 * 16384);
        for (int it = bid; it < 1280; it += G) {
            const float* W; unsigned char* WQ; float* SC; int N, n0, drow0;
            if (it < 576)      { const int m = it / 288, nb = it % 288; N = QKV_N; n0 = 32 * nb; drow0 = n0; W = ((const float*)(const GAS float*)a.in[4]) + (size_t)m * 1024 * QKV_N; WQ = ws + WS_WQKV + (size_t)m * QKV_N * 1024; SC = (float*)(ws + WS_WSQKV) + m * QKV_N; }
            else if (it < 768) { const int m = (it - 576) / 96, nb = (it - 576) % 96; N = 3072; n0 = 32 * nb; const int part = n0 >> 10, c = n0 & 1023; drow0 = (part == 0) ? (2048 + c) : (256 * (c >> 7) + (c & 127) + (part == 2 ? 128 : 0));
                                 W = ((const float*)(const GAS float*)a.in[6]) + (size_t)m * 1024 * 3072; WQ = ws + WS_WCIN + (size_t)m * 3072 * 1024; SC = (float*)(ws + WS_WSCIN) + m * 3072; }
            else if (it >= 1024) { const int m = (it - 1024) >> 6, nb = (it - 1024) & 63; N = PQ_N; n0 = 32 * nb; drow0 = n0; W = ((const float*)(const GAS float*)a.in[9]) + (size_t)m * 1024 * PQ_N; WQ = ws + WS_WPQ + (size_t)m * PQ_N * 1024; SC = (float*)(ws + WS_WSPQ) + m * PQ_N; }
            else               { const int m8 = (it - 768) >> 5; N = 1024; n0 = 32 * ((it - 768) & 31); drow0 = n0; SC = (float*)(ws + WS_WSC) + m8 * 1024;
                                 W = (m8 < 2) ? ((const float*)(const GAS float*)a.in[5]) + (size_t)m8 * 1024 * 1024 : (m8 < 4) ? ((const float*)(const GAS float*)a.in[8]) + (size_t)(m8 - 2) * 1024 * 1024 : ((const float*)(const GAS float*)a.in[18]) + (size_t)(m8 - 4) * 1024 * 1024;
                                 WQ = (m8 < 2) ? ws + WS_WO + (size_t)m8 * 1024 * 1024 : (m8 < 4) ? ws + WS_WCOUT + (size_t)(m8 - 2) * 1024 * 1024 : ws + WS_WG + (size_t)(m8 - 4) * 1024 * 1024; }
            const int ng = lane & 7, kq = lane >> 3, kb = 128 * wave + 16 * kq;
            const float* wp = W + (size_t)kb * N + n0 + 4 * ng;
            f32x4 t[16];
#pragma unroll
            for (int j = 0; j < 16; ++j) t[j] = *(const f32x4*)(wp + (size_t)j * N);
            f32x4 mx = {0.f, 0.f, 0.f, 0.f};
#pragma unroll
            for (int j = 0; j < 16; ++j) { mx.x = fmaxf(mx.x, fabsf(t[j].x)); mx.y = fmaxf(mx.y, fabsf(t[j].y)); mx.z = fmaxf(mx.z, fabsf(t[j].z)); mx.w = fmaxf(mx.w, fabsf(t[j].w)); }
#pragma unroll
            for (int o = 8; o < 64; o <<= 1) { mx.x = fmaxf(mx.x, __shfl_xor(mx.x, o)); mx.y = fmaxf(mx.y, __shfl_xor(mx.y, o)); mx.z = fmaxf(mx.z, __shfl_xor(mx.z, o)); mx.w = fmaxf(mx.w, __shfl_xor(mx.w, o)); }
            if (kq == 0) *(LAS f32x4*)(red + wave * 32 + 4 * ng) = mx;
            __syncthreads();
            f32x4 m4 = {0.f, 0.f, 0.f, 0.f};
#pragma unroll
            for (int w = 0; w < 8; ++w) { const f32x4 r = *(const LAS f32x4*)(red + w * 32 + 4 * ng); m4.x = fmaxf(m4.x, r.x); m4.y = fmaxf(m4.y, r.y); m4.z = fmaxf(m4.z, r.z); m4.w = fmaxf(m4.w, r.w); }
            f32x4 sc4, iv4;
            sc4.x = m4.x > 0.f ? m4.x * (1.0f / 127.0f) : 1.0f; sc4.y = m4.y > 0.f ? m4.y * (1.0f / 127.0f) : 1.0f; sc4.z = m4.z > 0.f ? m4.z * (1.0f / 127.0f) : 1.0f; sc4.w = m4.w > 0.f ? m4.w * (1.0f / 127.0f) : 1.0f;
            iv4.x = 1.0f / sc4.x; iv4.y = 1.0f / sc4.y; iv4.z = 1.0f / sc4.z; iv4.w = 1.0f / sc4.w;
            unsigned char* wq = WQ + (size_t)(drow0 + 4 * ng) * 1024 + kb;
#define WQ_ROW(c, cc) { v4u w; w.x = pack4_i8(t[0].c, t[1].c, t[2].c, t[3].c, iv4.c); w.y = pack4_i8(t[4].c, t[5].c, t[6].c, t[7].c, iv4.c); w.z = pack4_i8(t[8].c, t[9].c, t[10].c, t[11].c, iv4.c); w.w = pack4_i8(t[12].c, t[13].c, t[14].c, t[15].c, iv4.c); *(v4u*)(wq + (cc) * 1024) = w; }
            WQ_ROW(x, 0) WQ_ROW(y, 1) WQ_ROW(z, 2) WQ_ROW(w, 3)
#undef WQ_ROW
            if (wave == 0 && kq == 0) *(f32x4*)(SC + drow0 + 4 * ng) = sc4;
            __syncthreads();
        }
    }
    for (int mi = 0; mi < 20; ++mi) {
        if (mi < 12 || mi >= 16) continue;
        const float* W; bf16* WT; int K = 1024, N = 1024, mode = 0;
        if (mi < 2)       { W = ((const float*)(const GAS float*)a.in[4]) + (size_t)mi * 1024 * QKV_N;          WT = (bf16*)(ws + WS_WQKV) + (size_t)mi * QKV_N * 1024; N = QKV_N; }
        else if (mi < 4)  { W = ((const float*)(const GAS float*)a.in[5]) + (size_t)(mi - 2) * 1024 * 1024;    WT = (bf16*)(ws + WS_WO) + (size_t)(mi - 2) * 1024 * 1024; }
        else if (mi < 6)  { W = ((const float*)(const GAS float*)a.in[6]) + (size_t)(mi - 4) * 1024 * 3072;    WT = (bf16*)(ws + WS_WCIN) + (size_t)(mi - 4) * 3072 * 1024; N = 3072; mode = 1; }
        else if (mi < 8)  { W = ((const float*)(const GAS float*)a.in[8]) + (size_t)(mi - 6) * 1024 * 1024;    WT = (bf16*)(ws + WS_WCOUT) + (size_t)(mi - 6) * 1024 * 1024; }
        else if (mi < 12) { W = ((const float*)(const GAS float*)a.in[9]) + (size_t)(mi - 8) * 1024 * PQ_N;    WT = (bf16*)(ws + WS_WPQ) + (size_t)(mi - 8) * PQ_N * 1024; N = PQ_N; }
        else if (mi < 16) { W = ((const float*)(const GAS float*)a.in[17]) + (size_t)(mi - 12) * PLE_K * 1024; WT = (bf16*)(ws + WS_WPP) + (size_t)(mi - 12) * 1024 * PLE_K; K = PLE_K; }
        else              { W = ((const float*)(const GAS float*)a.in[18]) + (size_t)(mi - 16) * 1024 * 1024;  WT = (bf16*)(ws + WS_WG) + (size_t)(mi - 16) * 1024 * 1024; }
        const int nblk = N / 32, nitems = (K / 64) * nblk;
        for (int it = gw; it < nitems; it += NGW) {
            const int kb = it / nblk, nb = it % nblk, n0 = 32 * nb;
            int drow0 = n0;
            if (mode == 1) {
                const int part = n0 >> 10, c = n0 & 1023;
                drow0 = (part == 0) ? (2048 + c) : (256 * (c >> 7) + (c & 127) + (part == 2 ? 128 : 0));
            }
            transpose_item(W, K, N, WT, 64 * kb, n0, drow0, scr, lane);
        }
    }
    const size_t g0 = (size_t)bid * NTHR + tid, gs = (size_t)G * NTHR;
    cvt_range(((const float*)(const GAS float*)a.in[10]), (bf16*)(ws + WS_SK), (size_t)4 * 8 * 2 * 128 * 128 / 8, g0, gs);
    quant_rows_i4(((const float*)(const GAS float*)a.in[11]), ((const float*)(const GAS float*)a.in[12]), ws + WS_U, 4 * NEXP, lane, gw, NGW);
    for (int i = 0; i < 4; ++i) {
        cvt_range(((const float*)(const GAS float*)a.in[2]) + (size_t)i * 16384 * PLE_K, (bf16*)(ws + WS_PB) + (size_t)i * M_TOK * PLE_K, (size_t)16384 * PLE_K / 8, g0, gs);
        cvt_range(((const float*)(const GAS float*)a.in[3]) + (size_t)i * 32768 * PLE_K, (bf16*)(ws + WS_PB) + (size_t)i * M_TOK * PLE_K + (size_t)16384 * PLE_K, (size_t)32768 * PLE_K / 8, g0, gs);
    }
    cvt_range(((const float*)(const GAS float*)a.in[0]), (bf16*)(ws + WS_A2), (size_t)16384 * DM / 8, g0, gs);
    cvt_range(((const float*)(const GAS float*)a.in[1]), (bf16*)(ws + WS_A2) + (size_t)16384 * DM, (size_t)32768 * DM / 8, g0, gs);
    cvt_range_i8(((const float*)(const GAS float*)a.in[0]), ws + WS_A2Q, (size_t)16384 * DM / 8, g0, gs);
    cvt_range_i8(((const float*)(const GAS float*)a.in[1]), ws + WS_A2Q + (size_t)16384 * DM, (size_t)32768 * DM / 8, g0, gs);
    for (size_t e = g0; e < (size_t)SEQL * 16; e += gs) {
        const int pos = (int)(e >> 4), i = (int)(e & 15);
        const float ang = (float)pos * a.inv_freq[i];
        double s, c; sincos_d((double)ang, s, c);
        f32x2 o; o.x = (float)c; o.y = (float)s; ((f32x2*)(ws + WS_ROPE))[e] = o;
    }
}

__device__ __forceinline__ void ln_rows(bf16* XB, unsigned char* XQ, float* SA, const float* gain, const float* bias, int lane, int gw, int NGW) {
    float gv[16], bv[16];
#pragma unroll
    for (int q = 0; q < 4; ++q) { const f32x4 g4v = *(const f32x4*)(gain + (q >> 1) * 512 + 8 * lane + 4 * (q & 1)), b4v = *(const f32x4*)(bias + (q >> 1) * 512 + 8 * lane + 4 * (q & 1));
        gv[4 * q] = g4v.x; gv[4 * q + 1] = g4v.y; gv[4 * q + 2] = g4v.z; gv[4 * q + 3] = g4v.w; bv[4 * q] = b4v.x; bv[4 * q + 1] = b4v.y; bv[4 * q + 2] = b4v.z; bv[4 * q + 3] = b4v.w; }
    for (int r0 = gw; r0 < M_TOK; r0 += 2 * NGW) {
        v4u w[2][2];
#pragma unroll
        for (int j = 0; j < 2; ++j) { const int r = (r0 + j * NGW < M_TOK) ? r0 + j * NGW : r0; w[j][0] = *((const v4u*)(XB + (size_t)r * DM) + lane); w[j][1] = *((const v4u*)(XB + (size_t)r * DM + 512) + lane); }
#pragma unroll
        for (int j = 0; j < 2; ++j) { const int r = r0 + j * NGW; if (r < M_TOK) {
            float v[16]; float s = 0.f;
#pragma unroll
            for (int q = 0; q < 2; ++q) { const v4u x = w[j][q]; v[8 * q] = bflo(x.x); v[8 * q + 1] = bfhi(x.x); v[8 * q + 2] = bflo(x.y); v[8 * q + 3] = bfhi(x.y); v[8 * q + 4] = bflo(x.z); v[8 * q + 5] = bfhi(x.z); v[8 * q + 6] = bflo(x.w); v[8 * q + 7] = bfhi(x.w); }
#pragma unroll
            for (int e = 0; e < 16; ++e) s += v[e];
            const float mean = wave_sum(s) * (1.f / DM); float s2 = 0.f;
#pragma unroll
            for (int e = 0; e < 16; ++e) { v[e] -= mean; s2 += v[e] * v[e]; }
            const float rstd = 1.f / sqrtf(wave_sum(s2) * (1.f / DM) + LN_EPS);
#pragma unroll
            for (int e = 0; e < 16; ++e) v[e] = v[e] * rstd * gv[e] + bv[e];
#pragma unroll
            for (int q = 0; q < 2; ++q) { v4u o; o.x = pk2(v[8 * q], v[8 * q + 1]); o.y = pk2(v[8 * q + 2], v[8 * q + 3]); o.z = pk2(v[8 * q + 4], v[8 * q + 5]); o.w = pk2(v[8 * q + 6], v[8 * q + 7]); *((v4u*)(XB + (size_t)r * DM + 512 * q) + lane) = o; }
            float qi; const float sc = row_scale_i8(v, qi);
#pragma unroll
            for (int q = 0; q < 2; ++q) { v2u w; w.x = pack4_i8(v[8 * q], v[8 * q + 1], v[8 * q + 2], v[8 * q + 3], qi); w.y = pack4_i8(v[8 * q + 4], v[8 * q + 5], v[8 * q + 6], v[8 * q + 7], qi); *(v2u*)(XQ + (size_t)r * DM + 512 * q + 8 * lane) = w; }
            if (lane == 0) SA[r] = sc; } }
    }
}

__device__ __forceinline__ void attn_simple(const bf16* QKVp, bf16* Og, float* lse, int lane, int gw, int NGW) {
    const int NT = CH_SEQ * 3 * 8 * SEQL;
    const int per = (NT + NGW - 1) / NGW;
    const int t0 = gw * per, t1 = (t0 + per < NT) ? (t0 + per) : NT;
    for (int task = t0; task < t1; ++task) {
        const int tok = task & (SEQL - 1); const int pl = task >> 11; const int h = pl & 7; const int g = (pl >> 3) % 3; const int sq = pl / 24;
        const int sh = 2 * g, dil = 1 << sh, L = SEQL >> sh, r = tok & (dil - 1), p = tok >> sh;
        const bf16* Qp = QKVp + ((size_t)(((sq * 3 + g) * 3 + 0) * 8 + h) * SEQL) * 128;
        const bf16* Kp = QKVp + ((size_t)(((sq * 3 + g) * 3 + 1) * 8 + h) * SEQL) * 128;
        const bf16* Vp = QKVp + ((size_t)(((sq * 3 + g) * 3 + 2) * 8 + h) * SEQL) * 128;
        const v4u* qrow = (const v4u*)(Qp + (size_t)tok * 128);
        float sv[3];
#pragma unroll
        for (int e = 0; e < 3; ++e) {
            const int jj = lane + 64 * e; const int pp = p - 64 + jj; const bool ok = (jj <= 128) && (pp >= 0) && (pp < L);
            float s = -1e30f;
            if (ok) { const v4u* krow = (const v4u*)(Kp + (size_t)(r + dil * pp) * 128); float acc = 0.f;
#pragma unroll
                for (int c = 0; c < 16; ++c) { const v4u qv = qrow[c], kv = krow[c]; acc = dot2bf(qv.x, kv.x, acc); acc = dot2bf(qv.y, kv.y, acc); acc = dot2bf(qv.z, kv.z, acc); acc = dot2bf(qv.w, kv.w, acc); }
                s = acc; }
            sv[e] = s;
        }
        const float mx = wave_max(fmaxf(fmaxf(sv[0], sv[1]), sv[2]));
        float pv[3];
#pragma unroll
        for (int e = 0; e < 3; ++e) pv[e] = (sv[e] > -1e29f) ? exp2f(sv[e] - mx) : 0.f;
        const float den = wave_sum(pv[0] + pv[1] + pv[2]);
        float o0 = 0.f, o1 = 0.f;
        for (int jj = 0; jj <= 128; ++jj) {
            const float pj = __shfl(jj < 64 ? pv[0] : (jj < 128 ? pv[1] : pv[2]), jj & 63);
            if (pj != 0.f) { const int pp = p - 64 + jj; const unsigned vw = *((const unsigned*)(Vp + (size_t)(r + dil * pp) * 128) + lane); o0 += pj * bflo(vw); o1 += pj * bfhi(vw); }
        }
        const float inv = 1.f / den; const int row = sq * SEQL + tok;
        *((unsigned*)(Og + ((size_t)g * CH_ROWS + row) * DM + h * 128) + lane) = pk2(o0 * inv, o1 * inv);
        if (lane == 0) lse[((size_t)g * CH_ROWS + row) * 8 + h] = mx + log2f(den);
    }
}
typedef short s16x4 __attribute__((ext_vector_type(4)));
template <int OFF> __device__ __forceinline__ s16x4 tr_read(unsigned a) { s16x4 r; asm volatile("ds_read_b64_tr_b16 %0, %1 offset:%2" : "=&v"(r) : "v"(a), "i"(OFF) : "memory"); return r; }
constexpr int AT_RS = 288, AT_KOFF = 0, AT_VOFF = 256 * AT_RS;
template <int KP> __device__ __forceinline__ void attn_pv_step(f32x4 (&oacc)[8], unsigned vbase, bf16x8 pf) {
    s16x4 lo[8], hi[8];
#define AT_RD(DT) lo[DT] = tr_read<(32 * KP) * AT_RS + 32 * DT>(vbase); if constexpr (KP < 4) hi[DT] = tr_read<(32 * KP + 16) * AT_RS + 32 * DT>(vbase); else hi[DT] = (s16x4){0, 0, 0, 0};
    AT_RD(0) AT_RD(1) AT_RD(2) AT_RD(3) AT_RD(4) AT_RD(5) AT_RD(6) AT_RD(7)
#undef AT_RD
    asm volatile("s_waitcnt lgkmcnt(0)" ::: "memory"); __builtin_amdgcn_sched_barrier(0);
#pragma unroll
    for (int dt = 0; dt < 8; ++dt) { const bf16x8 vf = (bf16x8){lo[dt][0], lo[dt][1], lo[dt][2], lo[dt][3], hi[dt][0], hi[dt][1], hi[dt][2], hi[dt][3]};
        oacc[dt] = __builtin_amdgcn_mfma_f32_16x16x32_bf16(vf, pf, oacc[dt], 0, 0, 0); }
}
struct AttnUnit { const bf16 *Qpl, *Kpl, *Vpl; int g, h, sq, r, s, sh, dil, L; };
__device__ __forceinline__ AttnUnit attn_decode(const bf16* QKVp, int u) {
    AttnUnit a; const int w16 = u & 15; a.h = (u >> 4) & 7; a.g = (u >> 7) % 3; a.sq = u / 384;
    a.sh = 2 * a.g; a.dil = 1 << a.sh; a.L = SEQL >> a.sh; a.s = w16 & ((16 >> a.sh) - 1); a.r = w16 >> (4 - a.sh);
    const size_t pl = (size_t)((a.sq * 3 + a.g) * 3) * 8;
    a.Qpl = QKVp + ((pl + a.h) * SEQL) * 128; a.Kpl = QKVp + ((pl + 8 + a.h) * SEQL) * 128; a.Vpl = QKVp + ((pl + 16 + a.h) * SEQL) * 128;
    return a;
}
__device__ __forceinline__ void attn_fast(const bf16* QKVp, bf16* Og, float* lse, LAS unsigned char* lds, int tid, int lane, int wave, int bid, int G) {
    const int fr = lane & 15, g4 = lane >> 4;
    const int NU = CH_SEQ * 3 * 8 * 16;
    const int u0 = bid, u1 = NU, ustep = G;
    v4u kreg[8], vreg[4]; bf16x8 qn[4];
    if (u0 < u1) { const AttnUnit a = attn_decode(QKVp, u0);
        { const int qtok0 = a.r + a.dil * (128 * a.s + 16 * wave + fr);
#pragma unroll
          for (int ks = 0; ks < 4; ++ks) qn[ks] = *(const bf16x8*)(a.Qpl + (size_t)qtok0 * 128 + ks * 32 + g4 * 8); }
#pragma unroll
        for (int i = 0; i < 8; ++i) { const int cidx = tid + 512 * i, row = cidx >> 4, ch = cidx & 15; const int pp = 128 * a.s - 64 + row; const bool ok = (pp >= 0) && (pp < a.L); const size_t off = (size_t)(a.r + a.dil * pp) * 128 + ch * 8;
            kreg[i] = ok ? *(const v4u*)(a.Kpl + off) : (v4u){0u, 0u, 0u, 0u}; }
#pragma unroll
        for (int i = 0; i < 4; ++i) { const int cidx = tid + 512 * i, row = cidx >> 3, ch = cidx & 7; const int pp = 128 * a.s - 64 + row; const bool ok = (pp >= 0) && (pp < a.L);
            vreg[i] = ok ? *(const v4u*)((const unsigned char*)a.Vpl + (size_t)(a.r + a.dil * pp) * 128 + ch * 16) : (v4u){0u, 0u, 0u, 0u}; } }
    for (int u = u0; u < u1; u += ustep) {
        const AttnUnit a = attn_decode(QKVp, u);
        __syncthreads();
#pragma unroll
        for (int i = 0; i < 8; ++i) { const int cidx = tid + 512 * i, row = cidx >> 4, ch = cidx & 15;
            *(LAS v4u*)(lds + AT_KOFF + row * AT_RS + ch * 16) = kreg[i]; }
#pragma unroll
        for (int i = 0; i < 4; ++i) { const int cidx = tid + 512 * i, row = cidx >> 3, ch = cidx & 7; const v4u f8 = vreg[i]; v4u lo, hi;
#define F8BF(wd, ws) ({ const f32x2 t_ = __builtin_amdgcn_cvt_pk_f32_fp8((int)(wd), ws); pk2(t_[0], t_[1]); })
            lo.x = F8BF(f8.x, false); lo.y = F8BF(f8.x, true); lo.z = F8BF(f8.y, false); lo.w = F8BF(f8.y, true); hi.x = F8BF(f8.z, false); hi.y = F8BF(f8.z, true); hi.z = F8BF(f8.w, false); hi.w = F8BF(f8.w, true);
#undef F8BF
            *(LAS v4u*)(lds + AT_VOFF + row * AT_RS + ch * 32) = lo; *(LAS v4u*)(lds + AT_VOFF + row * AT_RS + ch * 32 + 16) = hi; }
        const int qtok = a.r + a.dil * (128 * a.s + 16 * wave + fr);
        bf16x8 qf[4];
#pragma unroll
        for (int ks = 0; ks < 4; ++ks) qf[ks] = qn[ks];
        __syncthreads();
        if (u + ustep < u1) { const AttnUnit b = attn_decode(QKVp, u + ustep);
            { const int qtokn = b.r + b.dil * (128 * b.s + 16 * wave + fr);
#pragma unroll
              for (int ks = 0; ks < 4; ++ks) qn[ks] = *(const bf16x8*)(b.Qpl + (size_t)qtokn * 128 + ks * 32 + g4 * 8); }
#pragma unroll
            for (int i = 0; i < 8; ++i) { const int cidx = tid + 512 * i, row = cidx >> 4, ch = cidx & 15; const int pp = 128 * b.s - 64 + row; const bool ok = (pp >= 0) && (pp < b.L); const size_t off = (size_t)(b.r + b.dil * pp) * 128 + ch * 8;
                kreg[i] = ok ? *(const v4u*)(b.Kpl + off) : (v4u){0u, 0u, 0u, 0u}; }
#pragma unroll
            for (int i = 0; i < 4; ++i) { const int cidx = tid + 512 * i, row = cidx >> 3, ch = cidx & 7; const int pp = 128 * b.s - 64 + row; const bool ok = (pp >= 0) && (pp < b.L);
                vreg[i] = ok ? *(const v4u*)((const unsigned char*)b.Vpl + (size_t)(b.r + b.dil * pp) * 128 + ch * 16) : (v4u){0u, 0u, 0u, 0u}; } }
        f32x4 sacc[9];
#pragma unroll
        for (int t = 0; t < 9; ++t) { f32x4 acc = {0.f, 0.f, 0.f, 0.f};
#pragma unroll
            for (int ks = 0; ks < 4; ++ks) { const bf16x8 kf = *(const LAS bf16x8*)(lds + AT_KOFF + (16 * (wave + t) + fr) * AT_RS + ks * 64 + g4 * 16);
                acc = __builtin_amdgcn_mfma_f32_16x16x32_bf16(kf, qf[ks], acc, 0, 0, 0); }
            sacc[t] = acc; }
        float mx = -1e30f;
#pragma unroll
        for (int t = 0; t < 9; ++t)
#pragma unroll
            for (int e = 0; e < 4; ++e) { const int dd = 16 * t + 4 * g4 + e - fr; const int pos = 128 * a.s - 64 + 16 * (wave + t) + 4 * g4 + e;
                const bool ok = (dd >= 0) && (dd <= 128) && (pos >= 0) && (pos < a.L); const float sv = ok ? sacc[t][e] : -1e30f; sacc[t][e] = sv; mx = fmaxf(mx, sv); }
        mx = fmaxf(mx, __shfl_xor(mx, 16)); mx = fmaxf(mx, __shfl_xor(mx, 32));
        float den = 0.f;
#pragma unroll
        for (int t = 0; t < 9; ++t)
#pragma unroll
            for (int e = 0; e < 4; ++e) { const float pv = (sacc[t][e] > -1e29f) ? __builtin_amdgcn_exp2f(sacc[t][e] - mx) : 0.f; sacc[t][e] = pv; den += pv; }
        den += __shfl_xor(den, 16); den += __shfl_xor(den, 32);
        bf16x8 pf[5];
#pragma unroll
        for (int kp = 0; kp < 5; ++kp) { v4u w; w.x = pk2(sacc[2 * kp][0], sacc[2 * kp][1]); w.y = pk2(sacc[2 * kp][2], sacc[2 * kp][3]);
            if (kp < 4) { w.z = pk2(sacc[2 * kp + 1][0], sacc[2 * kp + 1][1]); w.w = pk2(sacc[2 * kp + 1][2], sacc[2 * kp + 1][3]); } else { w.z = 0u; w.w = 0u; }
            pf[kp] = __builtin_bit_cast(bf16x8, w); }
        f32x4 oacc[8];
#pragma unroll
        for (int dt = 0; dt < 8; ++dt) oacc[dt] = (f32x4){0.f, 0.f, 0.f, 0.f};
        const unsigned vbase = (unsigned)(uintptr_t)(lds + AT_VOFF) + (unsigned)((16 * wave + 4 * g4 + ((lane & 15) >> 2)) * AT_RS + 8 * (lane & 3));
        attn_pv_step<0>(oacc, vbase, pf[0]); attn_pv_step<1>(oacc, vbase, pf[1]); attn_pv_step<2>(oacc, vbase, pf[2]); attn_pv_step<3>(oacc, vbase, pf[3]); attn_pv_step<4>(oacc, vbase, pf[4]);
        const float inv = 1.f / den; const size_t orow = (size_t)a.g * CH_ROWS + (size_t)a.sq * SEQL + qtok;
        bf16* op = Og + orow * DM + a.h * 128 + 4 * g4;
#pragma unroll
        for (int dt = 0; dt < 8; ++dt) { v2u w; w.x = pk2(oacc[dt][0] * inv, oacc[dt][1] * inv); w.y = pk2(oacc[dt][2] * inv, oacc[dt][3] * inv); *(v2u*)(op + 16 * dt) = w; }
        if (g4 == 0) lse[orow * 8 + a.h] = mx + log2f(den);
    }
}
__device__ __forceinline__ void combine_rows(const bf16* Og, const float* lse, unsigned char* OQ, float* SA, int lane, int gw, int NGW) {
    const int h = lane >> 3;
    for (int row0 = gw; row0 < CH_ROWS; row0 += 2 * NGW) {
        v4u x0[2][2], x1[2][2], x2[2][2]; float l0[2], l1[2], l2[2];
#pragma unroll
        for (int j = 0; j < 2; ++j) { const int row = (row0 + j * NGW < CH_ROWS) ? row0 + j * NGW : row0;
            l0[j] = lse[((size_t)0 * CH_ROWS + row) * 8 + h]; l1[j] = lse[((size_t)1 * CH_ROWS + row) * 8 + h]; l2[j] = lse[((size_t)2 * CH_ROWS + row) * 8 + h];
#pragma unroll
            for (int q = 0; q < 2; ++q) { x0[j][q] = *((const v4u*)(Og + ((size_t)0 * CH_ROWS + row) * DM) + 2 * lane + q); x1[j][q] = *((const v4u*)(Og + ((size_t)1 * CH_ROWS + row) * DM) + 2 * lane + q); x2[j][q] = *((const v4u*)(Og + ((size_t)2 * CH_ROWS + row) * DM) + 2 * lane + q); } }
#pragma unroll
        for (int j = 0; j < 2; ++j) { const int row = row0 + j * NGW; if (row < CH_ROWS) {
            const float mx = fmaxf(fmaxf(l0[j], l1[j]), l2[j]); float w0 = exp2f(l0[j] - mx), w1 = exp2f(l1[j] - mx), w2 = exp2f(l2[j] - mx); const float inv = 1.f / (w0 + w1 + w2); w0 *= inv; w1 *= inv; w2 *= inv;
            float r[16];
#pragma unroll
            for (int q = 0; q < 2; ++q) { const v4u a = x0[j][q], b = x1[j][q], c = x2[j][q];
#define CMB(cc, e) r[8 * q + e] = w0 * bflo(a.cc) + w1 * bflo(b.cc) + w2 * bflo(c.cc); r[8 * q + e + 1] = w0 * bfhi(a.cc) + w1 * bfhi(b.cc) + w2 * bfhi(c.cc);
                CMB(x, 0) CMB(y, 2) CMB(z, 4) CMB(w, 6)
#undef CMB
            }
            float qi; const float sc = row_scale_i8(r, qi);
            v4u w; w.x = pack4_i8(r[0], r[1], r[2], r[3], qi); w.y = pack4_i8(r[4], r[5], r[6], r[7], qi); w.z = pack4_i8(r[8], r[9], r[10], r[11], qi); w.w = pack4_i8(r[12], r[13], r[14], r[15], qi);
            *((v4u*)(OQ + (size_t)row * DM) + lane) = w;
            if (lane == 0) SA[row] = sc; } }
    }
}
__device__ __forceinline__ void conv_rows(const bf16* H, const bf16* GB, const float* ck, unsigned char* YQ, float* SA, int lane, int gw, int NGW) {
    float k0[16], k1[16], k2[16];
#pragma unroll
    for (int q = 0; q < 2; ++q)
#pragma unroll
        for (int e = 0; e < 2; ++e) { const int c0 = 512 * q + 8 * lane; const f32x4 a = *(const f32x4*)(ck + c0 + 4 * e), b = *(const f32x4*)(ck + DM + c0 + 4 * e), c = *(const f32x4*)(ck + 2 * DM + c0 + 4 * e);
            const int o = 8 * q + 4 * e; k0[o] = a.x; k0[o + 1] = a.y; k0[o + 2] = a.z; k0[o + 3] = a.w; k1[o] = b.x; k1[o + 1] = b.y; k1[o + 2] = b.z; k1[o + 3] = b.w; k2[o] = c.x; k2[o + 1] = c.y; k2[o + 2] = c.z; k2[o + 3] = c.w; }
    for (int row0 = gw; row0 < M_TOK; row0 += 2 * NGW) {
        v4u hm[2][2], hc[2][2], hn[2][2], gb[2][2];
#pragma unroll
        for (int j = 0; j < 2; ++j) { const int row = (row0 + j * NGW < M_TOK) ? row0 + j * NGW : row0; const int t = row & (SEQL - 1);
#pragma unroll
            for (int q = 0; q < 2; ++q) { const int c0 = 512 * q + 8 * lane;
                hm[j][q] = (t > 0) ? *(const v4u*)(H + (size_t)(row - 1) * DM + c0) : (v4u){0u, 0u, 0u, 0u};
                hc[j][q] = *(const v4u*)(H + (size_t)row * DM + c0);
                hn[j][q] = (t < SEQL - 1) ? *(const v4u*)(H + (size_t)(row + 1) * DM + c0) : (v4u){0u, 0u, 0u, 0u};
                gb[j][q] = *(const v4u*)(GB + (size_t)row * DM + c0); } }
#pragma unroll
        for (int j = 0; j < 2; ++j) { const int row = row0 + j * NGW; if (row < M_TOK) {
            float r[16];
#pragma unroll
            for (int q = 0; q < 2; ++q) { const v4u m_ = hm[j][q], c_ = hc[j][q], n_ = hn[j][q], g_ = gb[j][q];
#define CV(c, e) r[8 * q + e] = bflo(g_.c) * (k0[8 * q + e] * bflo(m_.c) + k1[8 * q + e] * bflo(c_.c) + k2[8 * q + e] * bflo(n_.c)); r[8 * q + e + 1] = bfhi(g_.c) * (k0[8 * q + e + 1] * bfhi(m_.c) + k1[8 * q + e + 1] * bfhi(c_.c) + k2[8 * q + e + 1] * bfhi(n_.c));
                CV(x, 0) CV(y, 2) CV(z, 4) CV(w, 6)
#undef CV
            }
            float qi; const float sc = row_scale_i8(r, qi);
#pragma unroll
            for (int q = 0; q < 2; ++q) { v2u w; w.x = pack4_i8(r[8 * q], r[8 * q + 1], r[8 * q + 2], r[8 * q + 3], qi); w.y = pack4_i8(r[8 * q + 4], r[8 * q + 5], r[8 * q + 6], r[8 * q + 7], qi);
                *(v2u*)(YQ + (size_t)row * DM + 512 * q + 8 * lane) = w; }
            if (lane == 0) SA[row] = sc; } }
    }
}
__device__ __forceinline__ void argmax_step(float& bv, int& bi) {
#pragma unroll
    for (int o = 1; o < 64; o <<= 1) { const float ov = __shfl_xor(bv, o); const int oi = __shfl_xor(bi, o); const bool take = (ov > bv) || (ov == bv && oi < bi); bv = take ? ov : bv; bi = take ? oi : bi; }
}
__device__ __forceinline__ void select_simple(const bf16* Qp, const bf16* SK, v2u* SEL, int lane, int gw, int NGW) {
    const int NT = M_TOK * 8;
    const int per = (NT + NGW - 1) / NGW;
    const int t0 = gw * per, t1 = (t0 + per < NT) ? (t0 + per) : NT;
    for (int task = t0; task < t1; ++task) {
        const int tok = task >> 3, h = task & 7;
        float topv[2]; int topi[2];
#pragma unroll
        for (int p = 0; p < 2; ++p) {
            const v4u* qrow = (const v4u*)(Qp + (size_t)tok * PQ_N + h * 256 + p * 128);
            const v4u* k0 = (const v4u*)(SK + ((size_t)(h * 2 + p) * 128 + lane) * 128);
            const v4u* k1 = (const v4u*)(SK + ((size_t)(h * 2 + p) * 128 + lane + 64) * 128);
            float s0 = 0.f, s1 = 0.f;
#pragma unroll
            for (int c = 0; c < 16; ++c) { const v4u qv = qrow[c], a = k0[c], b = k1[c];
                s0 = dot2bf(qv.x, a.x, s0); s0 = dot2bf(qv.y, a.y, s0); s0 = dot2bf(qv.z, a.z, s0); s0 = dot2bf(qv.w, a.w, s0);
                s1 = dot2bf(qv.x, b.x, s1); s1 = dot2bf(qv.y, b.y, s1); s1 = dot2bf(qv.z, b.z, s1); s1 = dot2bf(qv.w, b.w, s1); }
            float myv = -3e38f; int myi = 0;
            for (int k = 0; k < 16; ++k) {
                float bv = (s0 >= s1) ? s0 : s1; int bi = (s0 >= s1) ? lane : lane + 64;
                argmax_step(bv, bi);
                if (lane == k) { myv = bv; myi = bi; }
                if (bi == lane) s0 = -3e38f;
                if (bi == lane + 64) s1 = -3e38f;
            }
            topv[p] = myv; topi[p] = myi;
        }
        float cv[4];
        const float av = __shfl(topv[0], lane >> 2);
#pragma unroll
        for (int e = 0; e < 4; ++e) cv[e] = av + __shfl(topv[1], 4 * (lane & 3) + e);
        float fv = -3e38f; int fc = 0;
        for (int k = 0; k < 16; ++k) {
            float bv = cv[0]; int bi = 4 * lane;
#pragma unroll
            for (int e = 1; e < 4; ++e) if (cv[e] > bv) { bv = cv[e]; bi = 4 * lane + e; }
            argmax_step(bv, bi);
            if (lane == k) { fv = bv; fc = bi; }
#pragma unroll
            for (int e = 0; e < 4; ++e) if (bi == 4 * lane + e) cv[e] = -3e38f;
        }
        const int ea = __shfl(topi[0], (fc >> 4) & 15), eb = __shfl(topi[1], fc & 15);
        const float fmax_ = __shfl(fv, 0);
        const float ex = (lane < 16) ? __expf(fv - fmax_) : 0.f;
        const float sum = wave_sum(ex);
        if (lane < 16) { v2u o; o.x = (unsigned)(ea * 128 + eb); o.y = __builtin_bit_cast(unsigned, ex / sum); SEL[((size_t)tok * 8 + h) * 16 + lane] = o; }
    }
}
__device__ __forceinline__ int fkey(float f) { const int b = __builtin_bit_cast(int, f); return b ^ ((b >> 31) & 0x7fffffff); }
__device__ __forceinline__ float fkey_inv(int k) { const int b = k ^ ((k >> 31) & 0x7fffffff); return __builtin_bit_cast(float, b); }
__device__ __forceinline__ void list_insert(int (&L)[16], int x) {
#pragma unroll
    for (int i = 0; i < 16; ++i) { const int hi = max(L[i], x); x = min(L[i], x); L[i] = hi; }
}
#define CE_(a, b) do { t_ = max((a), (b)); (b) = min((a), (b)); (a) = t_; } while (0)
#define SORT16_DESC(K) do { int t_; \
 CE_(K[0], K[1]); CE_(K[2], K[3]); CE_(K[0], K[2]); CE_(K[1], K[3]); CE_(K[1], K[2]); CE_(K[4], K[5]); CE_(K[6], K[7]); CE_(K[4], K[6]); CE_(K[5], K[7]); \
 CE_(K[5], K[6]); CE_(K[0], K[4]); CE_(K[2], K[6]); CE_(K[2], K[4]); CE_(K[1], K[5]); CE_(K[3], K[7]); CE_(K[3], K[5]); CE_(K[1], K[2]); CE_(K[3], K[4]); \
 CE_(K[5], K[6]); CE_(K[8], K[9]); CE_(K[10], K[11]); CE_(K[8], K[10]); CE_(K[9], K[11]); CE_(K[9], K[10]); CE_(K[12], K[13]); CE_(K[14], K[15]); CE_(K[12], K[14]); \
 CE_(K[13], K[15]); CE_(K[13], K[14]); CE_(K[8], K[12]); CE_(K[10], K[14]); CE_(K[10], K[12]); CE_(K[9], K[13]); CE_(K[11], K[15]); CE_(K[11], K[13]); CE_(K[9], K[10]); \
 CE_(K[11], K[12]); CE_(K[13], K[14]); CE_(K[0], K[8]); CE_(K[4], K[12]); CE_(K[4], K[8]); CE_(K[2], K[10]); CE_(K[6], K[14]); CE_(K[6], K[10]); CE_(K[2], K[4]); \
 CE_(K[6], K[8]); CE_(K[10], K[12]); CE_(K[1], K[9]); CE_(K[5], K[13]); CE_(K[5], K[9]); CE_(K[3], K[11]); CE_(K[7], K[15]); CE_(K[7], K[11]); CE_(K[3], K[5]); \
 CE_(K[7], K[9]); CE_(K[11], K[13]); CE_(K[1], K[2]); CE_(K[3], K[4]); CE_(K[5], K[6]); CE_(K[7], K[8]); CE_(K[9], K[10]); CE_(K[11], K[12]); CE_(K[13], K[14]); \
 } while (0)
#define MERGE16_DESC(L, K) do { int t_; _Pragma("unroll") for (int i_ = 0; i_ < 16; ++i_) L[i_] = max(L[i_], K[15 - i_]); \
    _Pragma("unroll") for (int s_ = 8; s_ >= 1; s_ >>= 1) { _Pragma("unroll") for (int i_ = 0; i_ < 16; ++i_) if ((i_ & s_) == 0) CE_(L[i_], L[i_ + s_]); } } while (0)
constexpr float SL_BIAS = 96.0f;
constexpr int SL_RS = 272, SL_WAVE = 64 * SL_RS;
__device__ __forceinline__ void select_fast(const bf16* Qp_, const bf16* SK, v2u* SEL_, LAS unsigned char* lds, int lane, int wave, int u0, int u1, int du) {
    const int fr = lane & 15, g4 = lane >> 4, h = wave;
    LAS unsigned char* scr = lds + wave * SL_WAVE;
    for (int u = u0; u < u1; u += du) {
        const int tok0 = u * 64;
        int LA[16], LB[16];
#pragma unroll
        for (int i = 0; i < 16; ++i) { LA[i] = (int)0x80000000; LB[i] = (int)0x80000000; }
#pragma unroll
        for (int p = 0; p < 2; ++p) {
            bf16x8 qf[4][4];
#pragma unroll
            for (int tt = 0; tt < 4; ++tt)
#pragma unroll
                for (int ks = 0; ks < 4; ++ks) qf[tt][ks] = *(const bf16x8*)(Qp_ + (size_t)(tok0 + 16 * tt + fr) * PQ_N + h * 256 + p * 128 + ks * 32 + g4 * 8);
#pragma unroll 1
            for (int kh = 0; kh < 2; ++kh) {
                bf16x8 kf[4][4];
#pragma unroll
                for (int kt = 0; kt < 4; ++kt)
#pragma unroll
                    for (int ks = 0; ks < 4; ++ks) kf[kt][ks] = *(const bf16x8*)(SK + ((size_t)(h * 2 + p) * 128 + 64 * kh + 16 * kt + fr) * 128 + ks * 32 + g4 * 8);
#pragma unroll
                for (int kt = 0; kt < 4; ++kt)
#pragma unroll
                    for (int tt = 0; tt < 4; ++tt) { f32x4 acc = {0.f, 0.f, 0.f, 0.f};
#pragma unroll
                        for (int ks = 0; ks < 4; ++ks) acc = __builtin_amdgcn_mfma_f32_16x16x32_bf16(kf[kt][ks], qf[tt][ks], acc, 0, 0, 0);
                        *(LAS f32x4*)(scr + (16 * tt + fr) * SL_RS + (16 * kt + 4 * g4) * 4) = acc; }
                asm volatile("s_waitcnt lgkmcnt(0)" ::: "memory");
#pragma unroll
                for (int c4 = 0; c4 < 4; ++c4) { int K[16];
#pragma unroll
                    for (int q = 0; q < 4; ++q) { const f32x4 v = *(const LAS f32x4*)(scr + lane * SL_RS + (4 * c4 + q) * 16); const int ib = 64 * kh + 16 * c4 + 4 * q;
                        K[4 * q] = (__builtin_bit_cast(int, v.x + SL_BIAS) & ~127) | ib; K[4 * q + 1] = (__builtin_bit_cast(int, v.y + SL_BIAS) & ~127) | (ib + 1); K[4 * q + 2] = (__builtin_bit_cast(int, v.z + SL_BIAS) & ~127) | (ib + 2); K[4 * q + 3] = (__builtin_bit_cast(int, v.w + SL_BIAS) & ~127) | (ib + 3); }
                    SORT16_DESC(K);
                    if (p == 0) { MERGE16_DESC(LA, K); } else { MERGE16_DESC(LB, K); } }
                asm volatile("s_waitcnt lgkmcnt(0)" ::: "memory");
            }
        }
        float af[16], bfv[16];
#pragma unroll
        for (int i = 0; i < 16; ++i) { af[i] = __builtin_bit_cast(float, LA[i] & ~127); bfv[i] = __builtin_bit_cast(float, LB[i] & ~127);
            *(LAS int*)(scr + lane * SL_RS + 4 * i) = LA[i] & 127; *(LAS int*)(scr + lane * SL_RS + 64 + 4 * i) = LB[i] & 127; }
#define PAIRKEY(i, j) ((__builtin_bit_cast(int, af[i] + bfv[j]) & ~255) | ((15 - (i)) << 4) | (15 - (j)))
        int F[16];
#pragma unroll
        for (int j = 0; j < 16; ++j) F[j] = PAIRKEY(0, j);
        { int K[16] = {PAIRKEY(1, 0), PAIRKEY(1, 1), PAIRKEY(1, 2), PAIRKEY(1, 3), PAIRKEY(1, 4), PAIRKEY(1, 5), PAIRKEY(1, 6), PAIRKEY(1, 7), PAIRKEY(2, 0), PAIRKEY(2, 1), PAIRKEY(2, 2), PAIRKEY(2, 3), PAIRKEY(2, 4), PAIRKEY(3, 0), PAIRKEY(3, 1), PAIRKEY(3, 2)};
          SORT16_DESC(K); MERGE16_DESC(F, K); }
        { int K[16] = {PAIRKEY(3, 3), PAIRKEY(4, 0), PAIRKEY(4, 1), PAIRKEY(4, 2), PAIRKEY(5, 0), PAIRKEY(5, 1), PAIRKEY(6, 0), PAIRKEY(6, 1), PAIRKEY(7, 0), PAIRKEY(7, 1), PAIRKEY(8, 0), PAIRKEY(9, 0), PAIRKEY(10, 0), PAIRKEY(11, 0), PAIRKEY(12, 0), PAIRKEY(13, 0)};
          SORT16_DESC(K); MERGE16_DESC(F, K); }
        list_insert(F, PAIRKEY(14, 0)); list_insert(F, PAIRKEY(15, 0));
#undef PAIRKEY
        asm volatile("s_waitcnt lgkmcnt(0)" ::: "memory");
        float ev[16]; unsigned ex[16]; float sum = 0.f; const float f0 = __builtin_bit_cast(float, F[0] & ~255);
#pragma unroll
        for (int k = 0; k < 16; ++k) { const int code = F[k] & 255; const int ia = *(const LAS int*)(scr + lane * SL_RS + 4 * (15 - (code >> 4))); const int ib = *(const LAS int*)(scr + lane * SL_RS + 64 + 4 * (15 - (code & 15)));
            ex[k] = (unsigned)(ia * 128 + ib); ev[k] = __expf(__builtin_bit_cast(float, F[k] & ~255) - f0);     sum += ev[k]; }
        const float inv = 1.f / sum;
        { v4u* o = (v4u*)(SEL_ + ((size_t)(tok0 + lane) * 8 + h) * 16);
#pragma unroll
            for (int k = 0; k < 8; ++k) { v4u w; w.x = ex[2 * k]; w.y = __builtin_bit_cast(unsigned, ev[2 * k] * inv); w.z = ex[2 * k + 1]; w.w = __builtin_bit_cast(unsigned, ev[2 * k + 1] * inv); o[k] = w; } }
        asm volatile("s_waitcnt lgkmcnt(0)" ::: "memory");
    }
}
__device__ __forceinline__ float gelu_erf(float v) {
    const float t = __builtin_amdgcn_rcpf(fabsf(v) * 0.2316418882f + 1.0f);
    float q = t * 0.5307027145f + (-0.7265760135f); q = q * t + 0.7107068705f; q = q * t + (-0.142248368f); q = q * t + 0.127414796f; q = q * t;
    const float m = v * (q * __builtin_amdgcn_exp2f((v * v) * (-0.72134752044f)));
    return v < 0.f ? m : v - m;
}
__device__ __forceinline__ void gather_rows(float* X, bf16* XB, const v2u* SEL, const bf16* U, const bf16* V, const float* gain, const float* bias, int lane, int gw, int NGW) {
    for (int tok = gw; tok < M_TOK; tok += NGW) {
        const v2u sa = SEL[(size_t)tok * 128 + lane], sb = SEL[(size_t)tok * 128 + 64 + lane];
        const v4u x0 = *((const v4u*)(XB + (size_t)tok * DM) + lane), x1 = *((const v4u*)(XB + (size_t)tok * DM + 512) + lane);
        float f[16];
#pragma unroll
        for (int e = 0; e < 16; ++e) f[e] = 0.f;
        for (int b = 0; b < 32; ++b) {
            v4u u0[4], u1[4], w0[4], w1[4];
#pragma unroll
            for (int e = 0; e < 4; ++e) {
                const int k = 4 * b + e;
                const unsigned eid = (unsigned)__builtin_amdgcn_readlane((int)(k < 64 ? sa.x : sb.x), k & 63);
                const v4u* ur = (const v4u*)(U + (size_t)eid * DM); const v4u* vr = (const v4u*)(V + (size_t)eid * DM);
                u0[e] = ur[lane]; u1[e] = ur[64 + lane]; w0[e] = vr[lane]; w1[e] = vr[64 + lane];
            }
#pragma unroll
            for (int e = 0; e < 4; ++e) {
                const int k = 4 * b + e;
                float d = 0.f;
                d = dot2bf(u0[e].x, x0.x, d); d = dot2bf(u0[e].y, x0.y, d); d = dot2bf(u0[e].z, x0.z, d); d = dot2bf(u0[e].w, x0.w, d);
                d = dot2bf(u1[e].x, x1.x, d); d = dot2bf(u1[e].y, x1.y, d); d = dot2bf(u1[e].z, x1.z, d); d = dot2bf(u1[e].w, x1.w, d);
                d = wave_sum(d);
                const float gk = __builtin_bit_cast(float, (unsigned)__builtin_amdgcn_readlane((int)(k < 64 ? sa.y : sb.y), k & 63));
                const float c = gk * gelu_erf(d);
                f[0] += c * bflo(w0[e].x); f[1] += c * bfhi(w0[e].x); f[2] += c * bflo(w0[e].y); f[3] += c * bfhi(w0[e].y);
                f[4] += c * bflo(w0[e].z); f[5] += c * bfhi(w0[e].z); f[6] += c * bflo(w0[e].w); f[7] += c * bfhi(w0[e].w);
                f[8] += c * bflo(w1[e].x); f[9] += c * bfhi(w1[e].x); f[10] += c * bflo(w1[e].y); f[11] += c * bfhi(w1[e].y);
                f[12] += c * bflo(w1[e].z); f[13] += c * bfhi(w1[e].z); f[14] += c * bflo(w1[e].w); f[15] += c * bfhi(w1[e].w);
            }
        }
        float* xr = X + (size_t)tok * DM;
        float z[16];
#pragma unroll
        for (int q = 0; q < 4; ++q) { const f32x4 xv = *(const f32x4*)(xr + (q >> 1) * 512 + 8 * lane + 4 * (q & 1)); z[4 * q] = DN_ALPHA * xv.x + f[4 * q]; z[4 * q + 1] = DN_ALPHA * xv.y + f[4 * q + 1]; z[4 * q + 2] = DN_ALPHA * xv.z + f[4 * q + 2]; z[4 * q + 3] = DN_ALPHA * xv.w + f[4 * q + 3]; }
        float s = 0.f;
#pragma unroll
        for (int e = 0; e < 16; ++e) s += z[e];
        const float mean = wave_sum(s) * (1.f / DM); float s2 = 0.f;
#pragma unroll
        for (int e = 0; e < 16; ++e) { z[e] -= mean; s2 += z[e] * z[e]; }
        const float rstd = 1.f / sqrtf(wave_sum(s2) * (1.f / DM) + LN_EPS);
#pragma unroll
        for (int q = 0; q < 4; ++q) { const int c = (q >> 1) * 512 + 8 * lane + 4 * (q & 1); const f32x4 gv = *(const f32x4*)(gain + c), bv = *(const f32x4*)(bias + c);
            f32x4 o; o.x = z[4 * q] * rstd * gv.x + bv.x; o.y = z[4 * q + 1] * rstd * gv.y + bv.y; o.z = z[4 * q + 2] * rstd * gv.z + bv.z; o.w = z[4 * q + 3] * rstd * gv.w + bv.w;
            *(f32x4*)(xr + c) = o; v2u w; w.x = pk2(o.x, o.y); w.y = pk2(o.z, o.w); *(v2u*)(XB + (size_t)tok * DM + c) = w; }
    }
}

#define G8_ISSUE(UU, VV, B) do { const int b_ = (B); _Pragma("unroll") for (int e = 0; e < 8; ++e) { const int k_ = 8 * b_ + e; \
        const unsigned eid_ = (unsigned)__builtin_amdgcn_readlane((int)(b_ < 8 ? sa.x : sb.x), k_ & 63); \
        UU[e] = *((const v4u*)(U8 + (size_t)eid_ * DM) + lane); VV[e] = *((const v4u*)(V8 + (size_t)eid_ * DM) + lane); } } while (0)
#define G8_COMPUTE(UU, VV, B) do { const int b_ = (B); float d_[8]; \
        _Pragma("unroll") for (int e = 0; e < 8; ++e) { f32x2 acc_ = {0.f, 0.f}; \
            _Pragma("unroll") for (int w = 0; w < 4; ++w) { acc_ = __builtin_elementwise_fma(__builtin_amdgcn_cvt_pk_f32_fp8((int)UU[e][w], false), x[2 * w], acc_); acc_ = __builtin_elementwise_fma(__builtin_amdgcn_cvt_pk_f32_fp8((int)UU[e][w], true), x[2 * w + 1], acc_); } \
            d_[e] = acc_.x + acc_.y; } \
        float r_[4], q_[2], t_; \
        _Pragma("unroll") for (int i = 0; i < 4; ++i) { const float snd = h32 ? d_[i] : d_[i + 4], kp = h32 ? d_[i + 4] : d_[i]; r_[i] = kp + __shfl_xor(snd, 32); } \
        _Pragma("unroll") for (int i = 0; i < 2; ++i) { const float snd = h16 ? r_[i] : r_[i + 2], kp = h16 ? r_[i + 2] : r_[i]; q_[i] = kp + __shfl_xor(snd, 16); } \
        { const float snd = h8 ? q_[0] : q_[1], kp = h8 ? q_[1] : q_[0]; t_ = kp + __shfl_xor(snd, 8); } \
        t_ += __shfl_xor(t_, 4); t_ += __shfl_xor(t_, 2); t_ += __shfl_xor(t_, 1); \
        const int src_ = (8 * b_ + el) & 63; \
        const float gv_ = __builtin_bit_cast(float, __shfl((int)(b_ < 8 ? sa.y : sb.y), src_)), us_ = __builtin_bit_cast(float, __shfl((int)(b_ < 8 ? sa.z : sb.z), src_)); \
        const float cf_ = gv_ * gelu_erf(t_ * us_); \
        _Pragma("unroll") for (int e = 0; e < 8; ++e) { const float c_ = __builtin_bit_cast(float, __builtin_amdgcn_readlane(__builtin_bit_cast(int, cf_), 8 * e)); const f32x2 c2_ = {c_, c_}; \
            _Pragma("unroll") for (int w = 0; w < 4; ++w) { f[2 * w] = __builtin_elementwise_fma(__builtin_amdgcn_cvt_pk_f32_fp8((int)VV[e][w], false), c2_, f[2 * w]); f[2 * w + 1] = __builtin_elementwise_fma(__builtin_amdgcn_cvt_pk_f32_fp8((int)VV[e][w], true), c2_, f[2 * w + 1]); } } \
    } while (0)
__device__ __forceinline__ void gather_fp8(float* X, float* Xo, bf16* XB, const v4u* SEL_, const unsigned char* U8, const unsigned char* V8, const float* gain, const float* bias, int lane, int gw, int NGW) {
    const bool h32 = (lane & 32) != 0, h16 = (lane & 16) != 0, h8 = (lane & 8) != 0; const int el = (lane >> 3) & 7;
    for (int tok = gw; tok < M_TOK; tok += NGW) {
        const v4u sa = SEL_[(size_t)tok * 128 + lane], sb = SEL_[(size_t)tok * 128 + 64 + lane];
        float* xr = X + (size_t)tok * DM + 16 * lane;
        f32x2 x[8], f[8];
#pragma unroll
        for (int q = 0; q < 4; ++q) { const f32x4 xv = *((const f32x4*)xr + q); x[2 * q] = (f32x2){xv.x, xv.y}; x[2 * q + 1] = (f32x2){xv.z, xv.w}; f[2 * q] = (f32x2){0.f, 0.f}; f[2 * q + 1] = (f32x2){0.f, 0.f}; }
        v4u ua[8], va[8], ub[8], vb[8];
        G8_ISSUE(ua, va, 0);
#pragma unroll 1
        for (int bb = 0; bb < 8; ++bb) {
            G8_ISSUE(ub, vb, 2 * bb + 1);
            G8_COMPUTE(ua, va, 2 * bb);
            if (bb < 7) G8_ISSUE(ua, va, 2 * bb + 2);
            G8_COMPUTE(ub, vb, 2 * bb + 1);
        }
        float z[16];
#pragma unroll
        for (int q = 0; q < 8; ++q) { z[2 * q] = DN_ALPHA * x[q].x + f[q].x; z[2 * q + 1] = DN_ALPHA * x[q].y + f[q].y; }
        float s = 0.f;
#pragma unroll
        for (int e = 0; e < 16; ++e) s += z[e];
        const float mean = wave_sum(s) * (1.f / DM); float s2 = 0.f;
#pragma unroll
        for (int e = 0; e < 16; ++e) { z[e] -= mean; s2 += z[e] * z[e]; }
        const float rstd = 1.f / sqrtf(wave_sum(s2) * (1.f / DM) + LN_EPS);
        unsigned pw[8];
#pragma unroll
        for (int q = 0; q < 4; ++q) { const f32x4 gv = *((const f32x4*)(gain + 16 * lane) + q), bv = *((const f32x4*)(bias + 16 * lane) + q);
            f32x4 o; o.x = z[4 * q] * rstd * gv.x + bv.x; o.y = z[4 * q + 1] * rstd * gv.y + bv.y; o.z = z[4 * q + 2] * rstd * gv.z + bv.z; o.w = z[4 * q + 3] * rstd * gv.w + bv.w;
            *((f32x4*)(Xo + (size_t)tok * DM + 16 * lane) + q) = o; pw[2 * q] = pk2(o.x, o.y); pw[2 * q + 1] = pk2(o.z, o.w); }
        v4u* ob = (v4u*)(XB + (size_t)tok * DM + 16 * lane);
        ob[0] = (v4u){pw[0], pw[1], pw[2], pw[3]}; ob[1] = (v4u){pw[4], pw[5], pw[6], pw[7]};
    }
}
__device__ __forceinline__ float ub0(unsigned w) { float r; asm("v_cvt_f32_ubyte0 %0, %1" : "=v"(r) : "v"(w)); return r; }
__device__ __forceinline__ float ub1(unsigned w) { float r; asm("v_cvt_f32_ubyte1 %0, %1" : "=v"(r) : "v"(w)); return r; }
__device__ __forceinline__ float ub2(unsigned w) { float r; asm("v_cvt_f32_ubyte2 %0, %1" : "=v"(r) : "v"(w)); return r; }
__device__ __forceinline__ float ub3(unsigned w) { float r; asm("v_cvt_f32_ubyte3 %0, %1" : "=v"(r) : "v"(w)); return r; }
#define G4_ISSUE(DD, SS, B) do { const int b_ = (B); _Pragma("unroll") for (int e = 0; e < 4; ++e) { const int k_ = 4 * b_ + e; \
        const unsigned ro_ = (unsigned)__builtin_amdgcn_readlane((int)(b_ < 16 ? sa.x : sb.x), k_ & 63) * (unsigned)T4_ROW; \
        DD[e] = *(const v4u*)(T4 + (size_t)(ro_ + lane16)); SS[e] = *(const unsigned short*)(T4 + (size_t)(ro_ + 1024u + lane2x)); } } while (0)
#define G4_ISSUE_M(DD, SS, B, M) do { const int b_ = (B); _Pragma("unroll") for (int e = 0; e < 4; ++e) { const int k_ = 4 * b_ + e; \
        const unsigned ro_ = (unsigned)__builtin_amdgcn_readlane((int)(b_ < 16 ? sa.x : sb.x), k_ & 63) * (M); \
        DD[e] = *(const v4u*)(T4 + (size_t)(ro_ + lane16)); SS[e] = *(const unsigned short*)(T4 + (size_t)(ro_ + 1024u + lane2x)); } } while (0)
#define G4_COMPUTE(DD, SS, B) do { const int b_ = (B); float d_[4]; \
        _Pragma("unroll") for (int e = 0; e < 4; ++e) { const unsigned w0_ = DD[e].x, w1_ = DD[e].y; int di_ = 0; \
            di_ = __builtin_amdgcn_sdot4((int)(w0_ & 0x0F0F0F0Fu), xq[0], di_, false); di_ = __builtin_amdgcn_sdot4((int)((w0_ >> 4) & 0x0F0F0F0Fu), xq[1], di_, false); \
            di_ = __builtin_amdgcn_sdot4((int)(w1_ & 0x0F0F0F0Fu), xq[2], di_, false); di_ = __builtin_amdgcn_sdot4((int)((w1_ >> 4) & 0x0F0F0F0Fu), xq[3], di_, false); \
            d_[e] = __builtin_amdgcn_cvt_pk_f32_fp8((int)SS[e], false)[0] * ((float)di_ * sxl - xoffs); } \
        float q_[2], t_; \
          \
          \
        _Pragma("unroll") for (int i = 0; i < 2; ++i) { float a_ = d_[i], b_ = d_[i + 2]; asm volatile("s_nop 1\n\tv_permlane32_swap_b32 %0, %1" : "+v"(a_), "+v"(b_)); q_[i] = a_ + b_; } \
        { float a_ = q_[0], b_ = q_[1]; asm volatile("s_nop 1\n\tv_permlane16_swap_b32 %0, %1" : "+v"(a_), "+v"(b_)); t_ = a_ + b_; }     \
        t_ += __builtin_bit_cast(float, __builtin_amdgcn_update_dpp(0, __builtin_bit_cast(int, t_), 0x128, 0xf, 0xf, false));     \
        t_ += __builtin_bit_cast(float, __builtin_amdgcn_update_dpp(0, __builtin_bit_cast(int, t_), 0x124, 0xf, 0xf, false));     \
        t_ += __builtin_bit_cast(float, __builtin_amdgcn_update_dpp(0, __builtin_bit_cast(int, t_), 0x122, 0xf, 0xf, false));     \
        t_ += __builtin_bit_cast(float, __builtin_amdgcn_update_dpp(0, __builtin_bit_cast(int, t_), 0x121, 0xf, 0xf, false));     \
        const float gv_ = __builtin_bit_cast(float, __shfl((int)(b_ < 16 ? sa.y : sb.y), (4 * b_ + el) & 63)); \
        const float cf_ = gv_ * (1.0f / 1024.0f) * gelu_erf(t_); \
        _Pragma("unroll") for (int e = 0; e < 4; ++e) { const float c_ = __builtin_bit_cast(float, __builtin_amdgcn_readlane(__builtin_bit_cast(int, cf_), 16 * e)); \
            const float cs_ = c_ * __builtin_amdgcn_cvt_pk_f32_fp8((int)SS[e], false)[1]; const f32x2 cs2_ = {cs_, cs_}; \
            f2[0] = __builtin_elementwise_fma((f32x2)__builtin_amdgcn_cvt_scalef32_pk_f32_fp4(DD[e].z, 1.0f, 0), cs2_, f2[0]); f2[1] = __builtin_elementwise_fma((f32x2)__builtin_amdgcn_cvt_scalef32_pk_f32_fp4(DD[e].z, 1.0f, 1), cs2_, f2[1]); \
            f2[2] = __builtin_elementwise_fma((f32x2)__builtin_amdgcn_cvt_scalef32_pk_f32_fp4(DD[e].z, 1.0f, 2), cs2_, f2[2]); f2[3] = __builtin_elementwise_fma((f32x2)__builtin_amdgcn_cvt_scalef32_pk_f32_fp4(DD[e].z, 1.0f, 3), cs2_, f2[3]); \
            f2[4] = __builtin_elementwise_fma((f32x2)__builtin_amdgcn_cvt_scalef32_pk_f32_fp4(DD[e].w, 1.0f, 0), cs2_, f2[4]); f2[5] = __builtin_elementwise_fma((f32x2)__builtin_amdgcn_cvt_scalef32_pk_f32_fp4(DD[e].w, 1.0f, 1), cs2_, f2[5]); \
            f2[6] = __builtin_elementwise_fma((f32x2)__builtin_amdgcn_cvt_scalef32_pk_f32_fp4(DD[e].w, 1.0f, 2), cs2_, f2[6]); f2[7] = __builtin_elementwise_fma((f32x2)__builtin_amdgcn_cvt_scalef32_pk_f32_fp4(DD[e].w, 1.0f, 3), cs2_, f2[7]); } \
    } while (0)
__device__ __forceinline__ void sel_bucket_sort(v2u& sa, v2u& sb, int lane, LAS unsigned char* wl, bool rev) {
    const unsigned ba = sa.x >> 11, bb = sb.x >> 11;
    const unsigned long long lt = (1ull << lane) - 1ull;
    unsigned base = 0u, da = 0u, db = 0u;
#pragma unroll
    for (unsigned k = 0; k < 8; ++k) {
        const unsigned long long ma = __ballot(ba == k), mb = __ballot(bb == k);
        const unsigned ca = (unsigned)__popcll(ma), cb = (unsigned)__popcll(mb);
        da = (ba == k) ? base + (unsigned)__popcll(ma & lt) : da;
        db = (bb == k) ? base + ca + (unsigned)__popcll(mb & lt) : db;
        base += ca + cb;
    }
    da = rev ? 127u - da : da; db = rev ? 127u - db : db;
    *(LAS v2u*)(wl + 8u * da) = sa; *(LAS v2u*)(wl + 8u * db) = sb;
    asm volatile("s_waitcnt lgkmcnt(0)" ::: "memory");
    sa = *(const LAS v2u*)(wl + 8 * lane); sb = *(const LAS v2u*)(wl + 8 * (64 + lane));
    asm volatile("s_waitcnt lgkmcnt(0)" ::: "memory");
}
__device__ __forceinline__ void gather_i4(const bf16* XI, bf16* XB, unsigned char* XQ, float* SA, const v2u* SEL_, const unsigned char* T4, const float* gain, const float* bias, LAS unsigned char* wl, int lane, int t0, int t1, int dt) {
    const bool h32 = (lane & 32) != 0, h16 = (lane & 16) != 0; const int el = (lane >> 4) & 3; const unsigned lane16 = 16u * lane, lane2x = 2u * lane;
    v4u d0[4], d1[4], d2[4], d3[4], d4[4]; unsigned short sc0[4], sc1[4], sc2[4], sc3[4], sc4[4];
    v2u sa = {0u, 0u}, sb = {0u, 0u};
    v4u xn[2] = {{0u, 0u, 0u, 0u}, {0u, 0u, 0u, 0u}};
    if (t0 < t1) { sa = SEL_[(size_t)t0 * 128 + lane]; sb = SEL_[(size_t)t0 * 128 + 64 + lane]; xn[0] = *((const v4u*)(XI + (size_t)t0 * DM + 16 * lane)); xn[1] = *((const v4u*)(XI + (size_t)t0 * DM + 16 * lane) + 1); sel_bucket_sort(sa, sb, lane, wl, false); G4_ISSUE(d0, sc0, 0); G4_ISSUE(d1, sc1, 1); G4_ISSUE(d2, sc2, 2); G4_ISSUE(d3, sc3, 3); }
    for (int tok = t0; tok < t1; tok += dt) {
        const bool has_next = tok + dt < t1;
        f32x2 f2[8]; float sxl, xoffs; int xq[4];
        {
            float x[16];
#pragma unroll
            for (int q = 0; q < 2; ++q) { const v4u xv = xn[q]; x[8 * q] = bflo(xv.x); x[8 * q + 1] = bfhi(xv.x); x[8 * q + 2] = bflo(xv.y); x[8 * q + 3] = bfhi(xv.y); x[8 * q + 4] = bflo(xv.z); x[8 * q + 5] = bfhi(xv.z); x[8 * q + 6] = bflo(xv.w); x[8 * q + 7] = bfhi(xv.w); }
            float ax = 0.f;
#pragma unroll
            for (int e = 0; e < 16; ++e) { ax = fmaxf(ax, fabsf(x[e])); f2[e >> 1] = (f32x2){0.f, 0.f}; }
            sxl = (ax > 0.f) ? ax * (1.0f / 127.0f) : 1.0f; const float isx = 1.0f / sxl;
            int msum = 0;
#pragma unroll
            for (int w = 0; w < 4; ++w) { int pk = 0;
#pragma unroll
                for (int j = 0; j < 4; ++j) { const int idx = 8 * (w >> 1) + 2 * j + (w & 1); const int m = (int)rintf(x[idx] * isx); msum += m; pk |= (m & 0xff) << (8 * j); }
                xq[w] = pk; }
            xoffs = 7.5f * (float)msum * sxl * (1.0f / 1024.0f); sxl *= (1.0f / 1024.0f);
            asm volatile("" : "+v"(xq[0]), "+v"(xq[1]), "+v"(xq[2]), "+v"(xq[3]), "+v"(sxl), "+v"(xoffs));
        }
#pragma unroll 1
        for (int bb = 0; bb < 6; ++bb) {
            G4_ISSUE(d4, sc4, 5 * bb + 4);  G4_COMPUTE(d0, sc0, 5 * bb);
            G4_ISSUE(d0, sc0, 5 * bb + 5);  G4_COMPUTE(d1, sc1, 5 * bb + 1);
            G4_ISSUE(d1, sc1, 5 * bb + 6);  G4_COMPUTE(d2, sc2, 5 * bb + 2);
            if (bb < 5) G4_ISSUE(d2, sc2, 5 * bb + 7);  G4_COMPUTE(d3, sc3, 5 * bb + 3);
            if (bb < 5) G4_ISSUE(d3, sc3, 5 * bb + 8);  G4_COMPUTE(d4, sc4, 5 * bb + 4);
        }
        const int tokn = has_next ? tok + dt : tok;
        const v2u na = SEL_[(size_t)tokn * 128 + lane], nb = SEL_[(size_t)tokn * 128 + 64 + lane];
        G4_COMPUTE(d0, sc0, 30); G4_COMPUTE(d1, sc1, 31);
        int lane2 = lane; asm volatile("" : "+v"(lane2));
        const size_t eoff = (size_t)tok * DM + 16 * lane2;
        v4u xv2[2]; f32x4 gvv[4], bvv[4];
#pragma unroll
        for (int q = 0; q < 2; ++q) xv2[q] = *((const v4u*)(XI + eoff) + q);
#pragma unroll
        for (int q = 0; q < 4; ++q) { gvv[q] = *((const f32x4*)(gain + 16 * lane2) + q); bvv[q] = *((const f32x4*)(bias + 16 * lane2) + q); }
        xn[0] = *((const v4u*)(XI + (size_t)tokn * DM + 16 * lane2)); xn[1] = *((const v4u*)(XI + (size_t)tokn * DM + 16 * lane2) + 1);
        asm volatile("" ::: "memory");
        sa = na; sb = nb; sel_bucket_sort(sa, sb, lane, wl, (((tok - t0) / dt) & 1) == 0);
        { const unsigned rm_ = has_next ? (unsigned)T4_ROW : 0u;
          G4_ISSUE_M(d0, sc0, 0, rm_); G4_ISSUE_M(d1, sc1, 1, rm_); G4_ISSUE_M(d2, sc2, 2, rm_); G4_ISSUE_M(d3, sc3, 3, rm_); }
        asm volatile("" ::: "memory");
        float z[16]; float s = 0.f;
#pragma unroll
        for (int q = 0; q < 2; ++q) { const v4u xv = xv2[q];
            z[8 * q] = DN_ALPHA * bflo(xv.x) + f2[4 * q].x; z[8 * q + 1] = DN_ALPHA * bfhi(xv.x) + f2[4 * q].y; z[8 * q + 2] = DN_ALPHA * bflo(xv.y) + f2[4 * q + 1].x; z[8 * q + 3] = DN_ALPHA * bfhi(xv.y) + f2[4 * q + 1].y;
            z[8 * q + 4] = DN_ALPHA * bflo(xv.z) + f2[4 * q + 2].x; z[8 * q + 5] = DN_ALPHA * bfhi(xv.z) + f2[4 * q + 2].y; z[8 * q + 6] = DN_ALPHA * bflo(xv.w) + f2[4 * q + 3].x; z[8 * q + 7] = DN_ALPHA * bfhi(xv.w) + f2[4 * q + 3].y; }
#pragma unroll
        for (int e = 0; e < 16; ++e) s += z[e];
        const float mean = wave_sum(s) * (1.f / DM); float s2 = 0.f;
#pragma unroll
        for (int e = 0; e < 16; ++e) { z[e] -= mean; s2 += z[e] * z[e]; }
        const float rstd = 1.f / sqrtf(wave_sum(s2) * (1.f / DM) + LN_EPS);
        unsigned pw[8];
#pragma unroll
        for (int q = 0; q < 4; ++q) { const f32x4 gv = gvv[q], bv = bvv[q];
            z[4 * q] = z[4 * q] * rstd * gv.x + bv.x; z[4 * q + 1] = z[4 * q + 1] * rstd * gv.y + bv.y; z[4 * q + 2] = z[4 * q + 2] * rstd * gv.z + bv.z; z[4 * q + 3] = z[4 * q + 3] * rstd * gv.w + bv.w;
            pw[2 * q] = pk2(z[4 * q], z[4 * q + 1]); pw[2 * q + 1] = pk2(z[4 * q + 2], z[4 * q + 3]); }
        v4u* ob = (v4u*)(XB + eoff);
        ob[0] = (v4u){pw[0], pw[1], pw[2], pw[3]}; ob[1] = (v4u){pw[4], pw[5], pw[6], pw[7]};
        {
            float qi; const float sc = row_scale_i8(z, qi);
            v4u w; w.x = pack4_i8(z[0], z[1], z[2], z[3], qi); w.y = pack4_i8(z[4], z[5], z[6], z[7], qi); w.z = pack4_i8(z[8], z[9], z[10], z[11], qi); w.w = pack4_i8(z[12], z[13], z[14], z[15], qi);
            *(v4u*)(XQ + (size_t)tok * DM + 16 * lane2) = w;
            if (lane2 == 0) SA[tok] = sc;
        }
    }
}
__global__ void __launch_bounds__(NTHR, 2) mk_fwd(Args args) {
    extern __shared__ __attribute__((aligned(16))) unsigned char lds_raw[];
    LAS unsigned char* lds = (LAS unsigned char*)lds_raw;
    const int tid0_ = threadIdx.x, wave = __builtin_amdgcn_readfirstlane(tid0_ >> 6);
    const int G = gridDim.x, bid = blockIdx.x;
    const int gw = bid * NWAVES + wave, NGW = G * NWAVES;
    unsigned char* ws0_ = args.ws; float* X0_ = args.out;
    const int lo = args.ph_lo, hi = args.ph_hi;
    volatile LAS unsigned* MISC = (volatile LAS unsigned*)(lds + MISC_OFF);
    if (tid0_ < 128) MISC[tid0_] = 0u;
    __syncthreads();
    XcdBarrier bar; bar.bar = (unsigned*)(ws0_ + WS_CTL) + CW_BAR; bar.x = 0; bar.st = MISC;
    if (hi - lo > 1) bar = xcd_barrier_post((unsigned*)(ws0_ + WS_CTL) + CW_BAR, MISC);
    int ph = 0;
#define PH_BEGIN if (ph >= lo && ph < hi) { for (int prep_ = 0; prep_ < ((ph == PROBE_PH) ? 2 : 1); ++prep_) { int tid = tid0_; asm volatile("" : "+v"(tid)); const int lane = tid & 63; GAS unsigned char* wsg_ = (GAS unsigned char*)ws0_; asm volatile("" : "+s"(wsg_)); unsigned char* ws = (unsigned char*)wsg_; GAS float* Xg_ = (GAS float*)X0_; asm volatile("" : "+s"(Xg_)); float* X = (float*)Xg_; \
        bf16* A1 = (bf16*)(ws + WS_A1); bf16* A2 = (bf16*)(ws + WS_A2); bf16* A3 = (bf16*)(ws + WS_A3); unsigned char* A3Q = ws + WS_A3Q; unsigned char* A2Q = ws + WS_A2Q; (void)A2Q; unsigned char* A1Q = ws + WS_A1Q; float* SA1 = (float*)(ws + WS_SA1); float* SA3 = (float*)(ws + WS_SA3); (void)A1; (void)A2; (void)A3; (void)A3Q; (void)A1Q; (void)SA1; (void)SA3; (void)X; (void)lane; (void)tid;
#define PH_END   if (ph + 1 < hi) xcd_barrier(bar); } } ++ph;
#define GIN(k) ((const float*)(const GAS float*)args.in[k])
#define QKVp ((bf16*)(ws + WS_R1))
#define Og ((bf16*)(ws + WS_R2 + R2_OG))
#define lse ((float*)(ws + WS_R2 + R2_LSE))
#define Hc ((bf16*)(ws + WS_R1 + R1_H))
#define GBc ((bf16*)(ws + WS_R1 + R1_GB))
#define Qp ((bf16*)(ws + WS_R1 + R1_QP))
#define PP ((bf16*)(ws + WS_R1 + R1_PP))
#define SEL ((v2u*)(ws + WS_R2 + R2_SEL))

    PH_BEGIN for (int rep_ = 0; rep_ < 1 + PROBE_P; ++rep_) { prologue(args, ws, lds, tid, lane, wave, bid, G); __syncthreads(); } PH_END

    for (int i = 0; i < 4; ++i) {
        const int j = i >> 1;
        if ((i & 1) == 0) {
            for (int c = 0; c < NCHUNK; ++c) {
                PH_BEGIN {
                    pg8::Gemm g{(const bf16*)(A2Q + (size_t)c * CH_ROWS * DM), (const bf16*)(ws + WS_WQKV + (size_t)j * QKV_N * 1024), CH_ROWS, QKV_N, 512};
                    pg8::StaticOrder S; S.init(CH_ROWS, QKV_N, G, bid);
                    EpiQKV E{QKVp, (const f32x2*)(ws + WS_ROPE), (const float*)(ws + WS_WSQKV) + j * QKV_N};
#if PROBE_N
                    { EpiNull En; pg8::gemm_phase<EpiNull, pg8::StaticOrder, false>(lds, g, S, En, nullptr); __syncthreads(); }
#endif
                    for (int rep_ = 0; rep_ < 1 + PROBE_M; ++rep_) { pg8::gemm_phase<EpiQKV, pg8::StaticOrder, false, true>(lds, g, S, E, nullptr); __syncthreads(); }
                    if (c > 0) combine_rows(Og, lse, A3Q + (size_t)(c - 1) * CH_ROWS * DM, SA3 + (size_t)(c - 1) * CH_ROWS, lane, gw, NGW);
                } PH_END
                PH_BEGIN for (int rep_ = 0; rep_ < 1 + PROBE_A; ++rep_) { attn_fast(QKVp, Og, lse, lds, tid, lane, wave, bid, G); __syncthreads(); } PH_END
            }
            PH_BEGIN combine_rows(Og, lse, A3Q + (size_t)(NCHUNK - 1) * CH_ROWS * DM, SA3 + (size_t)(NCHUNK - 1) * CH_ROWS, lane, gw, NGW); PH_END
        } else {
            PH_BEGIN {
                pg8::Gemm g{(const bf16*)A2Q, (const bf16*)(ws + WS_WCIN + (size_t)j * 3072 * 1024), M_TOK, 3072, 512};
                pg8::StaticOrder S; S.init(M_TOK, 3072, G, bid);
                EpiCin E{Hc, GBc, (const float*)(ws + WS_WSCIN) + j * 3072};
                for (int rep_ = 0; rep_ < 1 + PROBE_M; ++rep_) { pg8::gemm_phase<EpiCin, pg8::StaticOrder, false, true>(lds, g, S, E, nullptr); __syncthreads(); }
            } PH_END
            PH_BEGIN for (int rep_ = 0; rep_ < 1 + PROBE_L; ++rep_) conv_rows(Hc, GBc, GIN(7) + (size_t)j * 3 * DM, A3Q, SA3, lane, gw, NGW); PH_END
        }
        PH_BEGIN {
            const unsigned char* Wt = (i & 1) ? ws + WS_WCOUT + (size_t)j * 1024 * 1024 : ws + WS_WO + (size_t)j * 1024 * 1024;
            pg8::Gemm g{(const bf16*)A3Q, (const bf16*)Wt, M_TOK, DM, 512};
            pg8::StaticOrder S; S.init(M_TOK, DM, G, bid);
            EpiResid E{A2, A1, SA3, (const float*)(ws + WS_WSC) + ((i & 1) ? 2 + j : j) * 1024};
            pg8::gemm_phase<EpiResid, pg8::StaticOrder, false, true>(lds, g, S, E, nullptr);
        } PH_END
        PH_BEGIN ln_rows(A1, A1Q, SA1, GIN(13) + (size_t)i * DM, GIN(14) + (size_t)i * DM, lane, gw, NGW); PH_END
        PH_BEGIN {
            {
                pg8::Gemm g{(const bf16*)A1Q, (const bf16*)(ws + WS_WPQ + (size_t)i * PQ_N * 1024), M_TOK, PQ_N, 512};
                pg8::StaticOrder S; S.init(M_TOK, PQ_N, G, bid);
                EpiQp E{Qp, SA1, (const float*)(ws + WS_WSPQ) + i * PQ_N};
                for (int rep_ = 0; rep_ < 1 + PROBE_M; ++rep_) { pg8::gemm_phase<EpiQp, pg8::StaticOrder, false, true>(lds, g, S, E, nullptr); __syncthreads(); }
            }
            __syncthreads();
            {
                pg8::Gemm g{(const bf16*)(ws + WS_PB) + (size_t)i * M_TOK * PLE_K, (const bf16*)(ws + WS_WPP) + (size_t)i * 1024 * PLE_K, M_TOK, DM, PLE_K};
                pg8::StaticOrder S; S.init(M_TOK, DM, G, bid);
                pg8::EpiBf16<0> E{PP, DM, nullptr, 0, 0};
                for (int rep_ = 0; rep_ < 1 + PROBE_M; ++rep_) { pg8::gemm_phase<pg8::EpiBf16<0>, pg8::StaticOrder, false>(lds, g, S, E, nullptr); __syncthreads(); }
            }
        } PH_END
        PH_BEGIN {
            const bf16* SKi = (const bf16*)(ws + WS_SK) + (size_t)i * 8 * 2 * 128 * 128; const unsigned char* T4i = ws + WS_U + (size_t)i * NEXP * T4_ROW;
            const int NU = M_TOK / 64, nu = (bid < NU) ? (NU - 1 - bid) / G + 1 : 0, pre = 1;
            int sdone = 0;
            for (int gdone = 0; gdone < nu; ++gdone) {
                while (sdone < nu && sdone < gdone + pre) {
                    const int u = bid + sdone * G; int t_ = tid0_; asm volatile("" : "+v"(t_)); select_fast(Qp, SKi, SEL, lds, t_ & 63, wave, u, u + 1, 1);
                    ++sdone; __syncthreads(); }
                { const int u = bid + gdone * G; int t_ = tid0_; asm volatile("" : "+v"(t_)); gather_i4(A1, A1, A1Q, SA1, SEL, T4i, GIN(15) + (size_t)i * DM, GIN(16) + (size_t)i * DM, lds + wave * SL_WAVE, t_ & 63, u * 64 + wave, u * 64 + 64, 8); }
            }
        } PH_END
        PH_BEGIN {
            pg8::Gemm g{(const bf16*)A1Q, (const bf16*)(ws + WS_WG + (size_t)i * 1024 * 1024), M_TOK, DM, 512};
            pg8::StaticOrder S; S.init(M_TOK, DM, G, bid);
            EpiGate E{A1, PP, A2, (i == 3) ? X : (float*)nullptr, SA1, (const float*)(ws + WS_WSC) + (4 + i) * 1024, A2Q};
            pg8::gemm_phase<EpiGate, pg8::StaticOrder, false, true>(lds, g, S, E, nullptr);
        } PH_END
    }
#undef PH_BEGIN
#undef GIN
#undef PH_END
#undef QKVp
#undef Og
#undef lse
#undef Hc
#undef GBc
#undef Qp
#undef PP
#undef SEL
}

extern "C" void kernel_launch(void* const* d_in, const int* in_sizes, int n_in, void* d_out, int out_size, void* d_ws, size_t ws_size, hipStream_t stream) {
    static int grid = 0;
    if (grid == 0) {
        if (n_in != 19 || out_size != M_TOK * DM || ws_size < WS_END) { fprintf(stderr, "kernel_launch: unexpected shapes (n_in %d out %d ws %zu)\n", n_in, out_size, ws_size); grid = -1; return; }
        int dev = 0, cus = 0, per_cu = 0;
        if (hipGetDevice(&dev) != hipSuccess || hipDeviceGetAttribute(&cus, hipDeviceAttributeMultiprocessorCount, dev) != hipSuccess) { grid = -1; return; }
        if (hipFuncSetAttribute((const void*)mk_fwd, hipFuncAttributeMaxDynamicSharedMemorySize, LDS_BYTES) != hipSuccess) { fprintf(stderr, "kernel_launch: hipFuncSetAttribute failed\n"); grid = -1; return; }
        if (hipOccupancyMaxActiveBlocksPerMultiprocessor(&per_cu, (const void*)mk_fwd, NTHR, LDS_BYTES) != hipSuccess || per_cu < 1) { fprintf(stderr, "kernel_launch: occupancy query says %d\n", per_cu); }
        (void)hipGetLastError();
        grid = cus;
    }
    if (grid < 0) return;
    (void)hipMemsetAsync((char*)d_ws + WS_CTL, 0, CTL_ZERO_BYTES, stream);
    Args a{};
    for (int i = 0; i < 19; ++i) a.in[i] = (const float*)d_in[i];
    a.out = (float*)d_out; a.ws = (unsigned char*)d_ws;
    static const float invf[16] = {1.0f, 0.44036659598350525f, 0.1939227432012558f, 0.08539710193872452f, 0.03760603070259094f, 0.01656043902039528f, 0.007292664609849453f, 0.0032114458736032248f,
                                   0.0014142135623842478f, 0.000622772378847003f, 0.00027424818836152554f, 0.00012076973507646471f, 5.318296098266728e-05f, 2.34199997066753e-05f, 1.0313386155758053e-05f, 4.541670477919979e-06f};
    for (int i = 0; i < 16; ++i) a.inv_freq[i] = invf[i];
#if ONE_LAUNCH
    a.ph_lo = 0; a.ph_hi = N_PHASES;
    hipLaunchKernelGGL(mk_fwd, dim3(grid), dim3(NTHR), LDS_BYTES, stream, a);
#else
    for (int p = 0; p < N_PHASES; ++p) { a.ph_lo = p; a.ph_hi = p + 1; hipLaunchKernelGGL(mk_fwd, dim3(grid), dim3(NTHR), LDS_BYTES, stream, a); }
#endif
}
```
